# Optimizing an MI355X kernel written in HIP

```python
import jax, jax.numpy as jnp
from jax import lax
import numpy as np

D_MODEL = 2048
BATCH = 4
SEQ = 2048
DEPTH = 4

MLA_HEADS = 8
MLA_Q_LORA = 512
MLA_KV_LORA = 512
MLA_NOPE = 128
MLA_ROPE = 64
MLA_V = 128
MLA_QK = MLA_NOPE + MLA_ROPE
MLSTM_HEADS = 4
MLSTM_DK = 128
MLSTM_DV = 256
MLSTM_CHUNK = 128
CONV_WIDTH = 4
FORGET_BIAS = 3.0
DIL_HEADS = 16
DIL_HEAD_DIM = 128
DIL_PATTERNS = ((128, 1), (512, 4), (2048, 16))
DIL_BLOCK = 128
Q_BLOCK = 128
D_FF = 4 * D_MODEL
ROPE_THETA = 10000.0
NORM_EPS = 1e-6
N_EVEN = (DEPTH + 1) // 2
N_ODD = DEPTH // 2
EVEN_SPLIT_SIZES = (MLA_Q_LORA, MLA_KV_LORA, MLA_ROPE, 2 * MLSTM_HEADS * MLSTM_DK,
                    MLSTM_HEADS * MLSTM_DV, MLSTM_HEADS, MLSTM_HEADS, MLSTM_HEADS * MLSTM_DV)
EVEN_IN = sum(EVEN_SPLIT_SIZES)
EVEN_MIX = MLA_HEADS * MLA_V + MLSTM_HEADS * MLSTM_DV
ODD_MIX = DIL_HEADS * DIL_HEAD_DIM

kernel_name = 'hybrid_mla_mlstm_dilated_trunk'


def rms_norm(x, g):
    x32 = x.astype(jnp.float32)
    y = x32 * lax.rsqrt(jnp.mean(x32 * x32, axis=-1, keepdims=True) + NORM_EPS)
    return (y * g.astype(jnp.float32)).astype(x.dtype)


def rope(x, pos):
    d = x.shape[-1]
    half = d // 2
    inv = ROPE_THETA ** (-jnp.arange(half, dtype=jnp.float32) * 2.0 / d)
    ang = pos.astype(jnp.float32)[:, None] * inv[None, :]
    cos, sin = jnp.cos(ang), jnp.sin(ang)
    x32 = x.astype(jnp.float32)
    x1, x2 = x32[..., :half], x32[..., half:]
    return jnp.concatenate([x1 * cos - x2 * sin, x1 * sin + x2 * cos], axis=-1).astype(x.dtype)


def causal_attention(q, k, v, scale):
    B, H, S, dq = q.shape
    dv = v.shape[-1]
    nb = S // Q_BLOCK
    qb = q.reshape(B, H, nb, Q_BLOCK, dq).transpose(2, 0, 1, 3, 4)
    kpos = jnp.arange(S)

    def one_block(args):
        q_blk, i = args
        s = jnp.einsum('bhqd,bhkd->bhqk', q_blk, k).astype(jnp.float32) * scale
        qpos = i * Q_BLOCK + jnp.arange(Q_BLOCK)
        s = jnp.where(kpos[None, :] <= qpos[:, None], s, -jnp.inf)
        p = jax.nn.softmax(s, axis=-1)
        return jnp.einsum('bhqk,bhkd->bhqd', p.astype(v.dtype), v)

    out = lax.map(one_block, (qb, jnp.arange(nb)))
    return out.transpose(1, 2, 0, 3, 4).reshape(B, H, S, dv)


def causal_depthwise_conv(x, w, b):
    C = x.shape[-1]
    y = lax.conv_general_dilated(x, w[:, None, :], window_strides=(1,),
                                 padding=((CONV_WIDTH - 1, 0),),
                                 dimension_numbers=('NWC', 'WIO', 'NWC'),
                                 feature_group_count=C)
    return y + b


def mlstm_chunkwise(q, k, v, ig, lf):
    B, H, S, dk = q.shape
    dv = v.shape[-1]
    L = MLSTM_CHUNK
    nc = S // L

    def chunks(t):
        return jnp.moveaxis(t.reshape((B, H, nc, L) + t.shape[3:]), 2, 0)

    xs = (chunks(q), chunks(k), chunks(v), chunks(ig), chunks(lf))
    tril = jnp.tril(jnp.ones((L, L), dtype=bool))

    def step(carry, inp):
        C, n, m_prev = carry
        qc, kc, vc, ic, fc = inp
        b = jnp.cumsum(fc, axis=-1)
        D = b[..., :, None] - b[..., None, :] + ic[..., None, :]
        D = jnp.where(tril, D, -jnp.inf)
        m_inter = b + m_prev[..., None]
        m_row = jnp.maximum(m_inter, jnp.max(D, axis=-1))
        W = jnp.exp(D - m_row[..., None]) * jnp.einsum('bhtd,bhsd->bhts', qc, kc)
        inter = jnp.exp(m_inter - m_row)
        num = jnp.einsum('bhts,bhsv->bhtv', W, vc) + inter[..., None] * jnp.einsum('bhtd,bhdv->bhtv', qc, C)
        den = jnp.sum(W, axis=-1) + inter * jnp.einsum('bhtd,bhd->bht', qc, n)
        h = num / jnp.maximum(jnp.abs(den), jnp.exp(-m_row))[..., None]
        bL = b[..., -1]
        g = bL[..., None] - b + ic
        m_new = jnp.maximum(bL + m_prev, jnp.max(g, axis=-1))
        wk = jnp.exp(g - m_new[..., None])
        decay = jnp.exp(bL + m_prev - m_new)
        C_new = decay[..., None, None] * C + jnp.einsum('bhsd,bhsv->bhdv', kc * wk[..., None], vc)
        n_new = decay[..., None] * n + jnp.einsum('bhs,bhsd->bhd', wk, kc)
        return (C_new, n_new, m_new), h

    init = (jnp.zeros((B, H, dk, dv), jnp.float32), jnp.zeros((B, H, dk), jnp.float32),
            jnp.zeros((B, H), jnp.float32))
    _, h = lax.scan(step, init, xs)
    return jnp.moveaxis(h, 0, 2).reshape(B, H, S, dv)


def even_mixer(h, pos, w_in, q_norm, w_uq, kv_norm, w_ukv, conv_w, conv_b, b_i, b_f, w_out):
    B, S, _ = h.shape
    proj = h @ w_in
    cuts = np.cumsum(EVEN_SPLIT_SIZES)[:-1].tolist()
    c_q, c_kv, k_r, m_qk, m_v, m_i, m_f, m_o = jnp.split(proj, cuts, axis=-1)

    q = (rms_norm(c_q, q_norm) @ w_uq).reshape(B, S, MLA_HEADS, MLA_QK).transpose(0, 2, 1, 3)
    q = jnp.concatenate([q[..., :MLA_NOPE], rope(q[..., MLA_NOPE:], pos)], axis=-1)
    kv = (rms_norm(c_kv, kv_norm) @ w_ukv).reshape(B, S, MLA_HEADS, MLA_NOPE + MLA_V).transpose(0, 2, 1, 3)
    k_nope, v = kv[..., :MLA_NOPE], kv[..., MLA_NOPE:]
    k_rope = rope(k_r, pos)[:, None]
    k = jnp.concatenate([k_nope, jnp.broadcast_to(k_rope, (B, MLA_HEADS, S, MLA_ROPE))], axis=-1)
    a_out = causal_attention(q, k, v, MLA_QK ** -0.5)
    a_out = a_out.transpose(0, 2, 1, 3).reshape(B, S, MLA_HEADS * MLA_V)

    qk = jax.nn.silu(causal_depthwise_conv(m_qk, conv_w, conv_b))
    mq, mk = jnp.split(qk, 2, axis=-1)
    heads = lambda t, e: t.reshape(B, S, MLSTM_HEADS, e).transpose(0, 2, 1, 3).astype(jnp.float32)
    mq = heads(mq, MLSTM_DK)
    mk = heads(mk, MLSTM_DK) * (MLSTM_DK ** -0.5)
    mv = heads(m_v, MLSTM_DV)
    ig = (m_i + b_i).astype(jnp.float32).transpose(0, 2, 1)
    lf = jax.nn.log_sigmoid((m_f + b_f).astype(jnp.float32)).transpose(0, 2, 1)
    hm = mlstm_chunkwise(mq, mk, mv, ig, lf)
    hm = hm.transpose(0, 2, 1, 3).reshape(B, S, MLSTM_HEADS * MLSTM_DV)
    hm = (jax.nn.sigmoid(m_o.astype(jnp.float32)) * hm).astype(h.dtype)

    return jnp.concatenate([a_out, hm], axis=-1) @ w_out


def dilated_branch(q, k, v, window, dilation):
    B, H, S, dh = q.shape
    span = window // dilation
    L = S // dilation
    nb = -(-L // DIL_BLOCK)
    Lp = nb * DIL_BLOCK

    def residues(t):
        t = t.reshape(B, H, L, dilation, dh).transpose(0, 1, 3, 2, 4)
        t = jnp.pad(t, ((0, 0), (0, 0), (0, 0), (0, Lp - L), (0, 0)))
        return t.reshape(B, H, dilation, nb, DIL_BLOCK, dh)

    def band(t):
        prev = jnp.pad(t, ((0, 0), (0, 0), (0, 0), (1, 0), (0, 0), (0, 0)))[:, :, :, :nb]
        return jnp.concatenate([prev, t], axis=4)

    qb = residues(q)
    kw, vw = band(residues(k)), band(residues(v))
    s = jnp.einsum('bhrnqd,bhrnkd->bhrnqk', qb, kw).astype(jnp.float32) * (dh ** -0.5)
    qi = jnp.arange(DIL_BLOCK)[:, None]
    kj = jnp.arange(2 * DIL_BLOCK)[None, :]
    dist = DIL_BLOCK + qi - kj
    key_sub = (jnp.arange(nb)[:, None, None] - 1) * DIL_BLOCK + kj[None]
    mask = (dist >= 0) & (dist <= span) & (key_sub >= 0)
    s = jnp.where(mask, s, -jnp.inf)
    m = jnp.max(s, axis=-1, keepdims=True)
    p = jnp.exp(s - m)
    den = jnp.sum(p, axis=-1)
    o = jnp.einsum('bhrnqk,bhrnkd->bhrnqd', p.astype(vw.dtype), vw).astype(jnp.float32) / den[..., None]
    lse = m[..., 0] + jnp.log(den)

    def merge(t):
        e = t.shape[-1]
        t = t.reshape(B, H, dilation, Lp, e)[:, :, :, :L]
        return t.transpose(0, 1, 3, 2, 4).reshape(B, H, S, e)

    return merge(o), merge(lse[..., None])[..., 0]


def odd_mixer(h, pos, w_qkv, w_out):
    B, S, _ = h.shape
    qkv = (h @ w_qkv).reshape(B, S, 3, DIL_HEADS, DIL_HEAD_DIM).transpose(2, 0, 3, 1, 4)
    q, k, v = rope(qkv[0], pos), rope(qkv[1], pos), qkv[2]
    outs, lses = [], []
    for window, dilation in DIL_PATTERNS:
        o_g, lse_g = dilated_branch(q, k, v, window, dilation)
        outs.append(o_g)
        lses.append(lse_g)
    alpha = jax.nn.softmax(jnp.stack(lses), axis=0)
    o = jnp.einsum('gbhs,gbhsd->bhsd', alpha, jnp.stack(outs))
    o = o.transpose(0, 2, 1, 3).reshape(B, S, ODD_MIX).astype(h.dtype)
    return o @ w_out


def squared_relu_mlp(h, w1, w2):
    return jnp.square(jax.nn.relu(h @ w1)) @ w2


def setup_inputs(seed: int = 0) -> dict:
    key = jax.random.key(seed)
    ks = jax.random.split(key, 18)
    f32 = jnp.float32
    res = (2 * DEPTH) ** -0.5

    def dense(k, shape, fan_in, gain=1.0):
        return jax.random.normal(k, shape, f32) * (gain * fan_in ** -0.5)

    def norm_gain(k, shape):
        return 1.0 + 0.05 * jax.random.normal(k, shape, f32)

    return {
        'x': jax.random.normal(ks[0], (BATCH, SEQ, D_MODEL), f32),
        'norm_mix': norm_gain(ks[1], (DEPTH, D_MODEL)),
        'norm_mlp': norm_gain(ks[2], (DEPTH, D_MODEL)),
        'ev_w_in': dense(ks[3], (N_EVEN, D_MODEL, EVEN_IN), D_MODEL),
        'mla_q_norm': norm_gain(ks[4], (N_EVEN, MLA_Q_LORA)),
        'mla_w_uq': dense(ks[5], (N_EVEN, MLA_Q_LORA, MLA_HEADS * MLA_QK), MLA_Q_LORA),
        'mla_kv_norm': norm_gain(ks[6], (N_EVEN, MLA_KV_LORA)),
        'mla_w_ukv': dense(ks[7], (N_EVEN, MLA_KV_LORA, MLA_HEADS * (MLA_NOPE + MLA_V)), MLA_KV_LORA),
        'mlstm_conv_w': dense(ks[8], (N_EVEN, CONV_WIDTH, 2 * MLSTM_HEADS * MLSTM_DK), CONV_WIDTH),
        'mlstm_conv_b': 0.01 * jax.random.normal(ks[9], (N_EVEN, 2 * MLSTM_HEADS * MLSTM_DK), f32),
        'mlstm_b_i': 0.1 * jax.random.normal(ks[10], (N_EVEN, MLSTM_HEADS), f32),
        'mlstm_b_f': FORGET_BIAS + 0.1 * jax.random.normal(ks[11], (N_EVEN, MLSTM_HEADS), f32),
        'ev_w_out': dense(ks[12], (N_EVEN, EVEN_MIX, D_MODEL), EVEN_MIX, res),
        'od_w_qkv': dense(ks[13], (N_ODD, D_MODEL, 3 * ODD_MIX), D_MODEL),
        'od_w_out': dense(ks[14], (N_ODD, ODD_MIX, D_MODEL), ODD_MIX, res),
        'mlp_w1': dense(ks[15], (DEPTH, D_MODEL, D_FF), D_MODEL),
        'mlp_w2': dense(ks[16], (DEPTH, D_FF, D_MODEL), D_FF, res),
        'norm_final': norm_gain(ks[17], (D_MODEL,)),
    }


def reference(x, norm_mix, norm_mlp, ev_w_in, mla_q_norm, mla_w_uq, mla_kv_norm, mla_w_ukv,
              mlstm_conv_w, mlstm_conv_b, mlstm_b_i, mlstm_b_f, ev_w_out, od_w_qkv, od_w_out,
              mlp_w1, mlp_w2, norm_final):
    pos = jnp.arange(x.shape[1])
    for layer in range(DEPTH):
        i = layer // 2
        h = rms_norm(x, norm_mix[layer])
        if layer % 2 == 0:
            mix = even_mixer(h, pos, ev_w_in[i], mla_q_norm[i], mla_w_uq[i], mla_kv_norm[i],
                             mla_w_ukv[i], mlstm_conv_w[i], mlstm_conv_b[i], mlstm_b_i[i],
                             mlstm_b_f[i], ev_w_out[i])
        else:
            mix = odd_mixer(h, pos, od_w_qkv[i], od_w_out[i])
        x = x + mix
        x = x + squared_relu_mlp(rms_norm(x, norm_mlp[layer]), mlp_w1[layer], mlp_w2[layer])
    return rms_norm(x, norm_final)
```

```cpp
#include <hip/hip_runtime.h>
#include <hip/hip_cooperative_groups.h>
#include <cstdio>
#include <cstdint>
namespace cg = cooperative_groups;

#define LAS __attribute__((address_space(3)))
#define GAS __attribute__((address_space(1)))
typedef unsigned short bf16_t;
typedef short bf16x8 __attribute__((ext_vector_type(8)));
typedef short s16x4 __attribute__((ext_vector_type(4)));
typedef float f32x4 __attribute__((ext_vector_type(4)));
typedef float f32x2 __attribute__((ext_vector_type(2)));
typedef unsigned u32x4 __attribute__((ext_vector_type(4)));
typedef unsigned u32x2 __attribute__((ext_vector_type(2)));

constexpr int T = 8192, SEQ = 2048, DM = 2048, FF = 8192;
constexpr int NIN = 4352;
constexpr float EPS = 1e-6f;
constexpr float LOG2E = 1.4426950408889634f;
constexpr int LDS_BYTES = 152 * 1024;
constexpr int QWORD_OFF = LDS_BYTES - 16;

constexpr size_t OFF_CTL = 0;
constexpr size_t OFF_BAR = 4096;
constexpr size_t CTL_BYTES = 4096 + 16384;
constexpr size_t OFF_ROPEA = CTL_BYTES;
constexpr size_t OFF_ROPEB = OFF_ROPEA + (size_t)2048 * 32 * 8;
constexpr size_t OFF_SSX = OFF_ROPEB + (size_t)2048 * 64 * 8;
constexpr size_t OFF_SSCQ = OFF_SSX + (size_t)T * 32 * 4;
constexpr size_t OFF_SSCKV = OFF_SSCQ + (size_t)T * 8 * 4;
constexpr size_t OFF_X = OFF_SSCKV + (size_t)T * 8 * 4;
constexpr size_t OFF_XB = OFF_X + (size_t)T * DM * 4;
constexpr size_t OFF_W = OFF_XB + (size_t)T * DM * 2;
constexpr size_t SZ_WIN = (size_t)NIN * 2048 * 2, SZ_WUQ = (size_t)1536 * 512 * 2, SZ_WUKV = (size_t)2048 * 512 * 2,
                 SZ_WO = (size_t)2048 * 2048 * 2, SZ_WQKV = (size_t)6144 * 2048 * 2, SZ_W1 = (size_t)8192 * 2048 * 2;
constexpr size_t OFF_WIN = OFF_W;
constexpr size_t OFF_WUQ = OFF_WIN + 2 * SZ_WIN;
constexpr size_t OFF_WUKV = OFF_WUQ + 2 * SZ_WUQ;
constexpr size_t OFF_WEVO = OFF_WUKV + 2 * SZ_WUKV;
constexpr size_t OFF_WQKV = OFF_WEVO + 2 * SZ_WO;
constexpr size_t OFF_WODO = OFF_WQKV + 2 * SZ_WQKV;
constexpr size_t OFF_W1 = OFF_WODO + 2 * SZ_WO;
constexpr size_t OFF_W2 = OFF_W1 + 4 * SZ_W1;
constexpr size_t OFF_UN = OFF_W2 + 4 * SZ_W1;
constexpr size_t OFF_CQ = OFF_UN;
constexpr size_t OFF_CKV = OFF_CQ + (size_t)T * 512 * 2;
constexpr size_t OFF_MRAW = OFF_CKV + (size_t)T * 512 * 2;
constexpr size_t OFF_MV = OFF_MRAW + (size_t)T * 1024 * 4;
constexpr size_t OFF_MO = OFF_MV + (size_t)T * 1024 * 2;
constexpr size_t OFF_KROPE = OFF_MO + (size_t)T * 1024 * 2;
constexpr size_t OFF_GATES = OFF_KROPE + (size_t)T * 64 * 2;
constexpr size_t OFF_QB = OFF_GATES + (size_t)T * 8 * 4;
constexpr size_t OFF_KNOPE = OFF_QB + (size_t)T * 1536 * 2;
constexpr size_t OFF_VB = OFF_KNOPE + (size_t)T * 1024 * 2;
constexpr size_t OFF_MIXE = OFF_VB + (size_t)T * 1024 * 2;
constexpr size_t OFF_MQ = OFF_MIXE + (size_t)T * 2048 * 2;
constexpr size_t OFF_MK = OFF_MQ + (size_t)T * 512 * 2;
constexpr size_t OFF_KLOC = OFF_MK + (size_t)T * 512 * 2;
constexpr size_t OFF_NLOC = OFF_KLOC + (size_t)256 * 256 * 128 * 4;
constexpr size_t OFF_MSC = OFF_NLOC + (size_t)256 * 128 * 4;
constexpr size_t OFF_PART = OFF_MSC + 4096;
constexpr size_t END_EVEN = OFF_PART + (size_t)8 * T * 72 * 4;
constexpr size_t OFF_QKV = OFF_UN;
constexpr size_t OFF_OG = OFF_QKV + (size_t)T * 6144 * 2;
constexpr size_t OFF_LSE = OFF_OG + (size_t)3 * T * 2048 * 2;
constexpr size_t OFF_MIXO = OFF_LSE + (size_t)3 * T * 16 * 4;
constexpr size_t END_ODD = OFF_MIXO + (size_t)T * 2048 * 2;
constexpr size_t OFF_U = OFF_UN;
constexpr size_t END_U = OFF_U + (size_t)T * FF * 2;
constexpr size_t WS_END = (END_ODD > END_EVEN ? (END_ODD > END_U ? END_ODD : END_U) : (END_EVEN > END_U ? END_EVEN : END_U));

struct Params {
    const float *x, *norm_mix, *norm_mlp, *ev_w_in, *mla_q_norm, *mla_w_uq, *mla_kv_norm, *mla_w_ukv, *conv_w, *conv_b, *b_i, *b_f,
        *ev_w_out, *od_w_qkv, *od_w_out, *mlp_w1, *mlp_w2, *norm_final;
    float* out;
    unsigned char* ws;
};

__device__ __forceinline__ unsigned char* opaque_ws(const Params& p) { unsigned char* w = p.ws; asm volatile("" : "+s"(w)); return w; }

__device__ __forceinline__ unsigned f2bf(float f) { unsigned u = __float_as_uint(f); u += 0x7FFFu + ((u >> 16) & 1u); return u >> 16; }
typedef __bf16 bf16v2_ __attribute__((ext_vector_type(2)));
__device__ __forceinline__ unsigned pk2(float lo, float hi) { f32x2 v = {lo, hi}; bf16v2_ r = __builtin_convertvector(v, bf16v2_); return __builtin_bit_cast(unsigned, r); }
__device__ __forceinline__ float bf2f(unsigned short b) { return __uint_as_float(((unsigned)b) << 16); }
__device__ __forceinline__ float bflo(unsigned w) { return __uint_as_float(w << 16); }
__device__ __forceinline__ float bfhi(unsigned w) { return __uint_as_float(w & 0xFFFF0000u); }
__device__ __forceinline__ u32x4 pk8(f32x4 a, f32x4 b) { u32x4 o; o.x = pk2(a[0], a[1]); o.y = pk2(a[2], a[3]); o.z = pk2(b[0], b[1]); o.w = pk2(b[2], b[3]); return o; }
__device__ __forceinline__ float wave_sum(float v) {
#pragma unroll
    for (int o = 1; o < 64; o <<= 1) v += __shfl_xor(v, o);
    return v;
}
__device__ __forceinline__ float sigmoidf_(float x) { return 1.0f / (1.0f + __expf(-x)); }
__device__ __forceinline__ float row_rstd(const float* ss, int nslots, float invn) {
    float s = 0.f;
    for (int i = 0; i < nslots; i += 4) { f32x4 v = *(const GAS f32x4*)(ss + i); s += (v[0] + v[1]) + (v[2] + v[3]); }
    return rsqrtf(s * invn + EPS);
}
__device__ __forceinline__ bf16x8 mk8(s16x4 a, s16x4 b) { bf16x8 r; r[0] = a[0]; r[1] = a[1]; r[2] = a[2]; r[3] = a[3]; r[4] = b[0]; r[5] = b[1]; r[6] = b[2]; r[7] = b[3]; return r; }
__device__ __forceinline__ s16x4 lds_tr(LAS unsigned char* p) { return __builtin_amdgcn_ds_read_tr16_b64_v4i16((LAS s16x4*)p); }
__device__ __forceinline__ f32x4 mfma16(bf16x8 a, bf16x8 b, f32x4 c) { return __builtin_amdgcn_mfma_f32_16x16x32_bf16(a, b, c, 0, 0, 0); }

namespace pg8 {
constexpr int BM = 256, BK = 64, HALF = 128, HTB = HALF * BK * 2, STAGE_BYTES = 8 * HTB, NXCD = 8, WGM = 8;
__host__ __device__ __forceinline__ int lds_byte(int r, int c) { const int st = (r >> 4) * 2 + (c >> 5), rr = r & 15, cc = c & 31, ob = rr * 64 + cc * 2; return st * 1024 + (ob ^ (((ob >> 9) & 1) << 5)); }
__host__ __device__ __forceinline__ void stage_rc(int b, int& R, int& C) { const int st = b / 1024, sb = b % 1024, swz = sb ^ (((sb >> 9) & 1) << 5); R = (st >> 1) * 16 + swz / 64; C = (st & 1) * 32 + (swz % 64) / 2; }
__host__ __device__ __forceinline__ int perm32(int rho) { const int n = rho >> 4, i = rho & 15; return 8 * (i >> 2) + 4 * n + (i & 3); }
struct Unit { int pm, pn, i; };
struct Gemm { const bf16_t* A; const bf16_t* Bt; int M, N, K, ldA, ldB, splitk; size_t kstepA, kstepB; };
struct StaticOrder {
    int nM, nN, nwg, G, c;
    __host__ __device__ void init(int M, int N, int G_, int c_) { nM = M / BM; nN = N / BM; nwg = nM * nN; G = G_; c = c_; }
    __host__ __device__ bool next(int i, Unit& u) const {
        const long L = (long)i * G + c; if (L >= nwg) return false;
        int wgid = (int)L; { const int q = nwg / NXCD, r = nwg % NXCD, xcd = wgid % NXCD, off = wgid / NXCD; wgid = (xcd < r ? xcd * (q + 1) : r * (q + 1) + (xcd - r) * q) + off; }
        const int nig = WGM * nN, gid = wgid / nig, fm = gid * WGM, gsz = (nM - fm) < WGM ? (nM - fm) : WGM;
        u.pm = fm + ((wgid % nig) % gsz); u.pn = (wgid % nig) / gsz; return true;
    }
    __device__ __forceinline__ void a_ready(const Unit&) const {}
    __device__ __forceinline__ void done(const Unit&) const {}
};

template <class Epi, class Sched, bool ALIGN_EPI = false, bool SP2 = false>
__device__ __forceinline__ void gemm_phase(LAS unsigned char* lds, const Gemm g, const Sched& S, const Epi& E) {
    int tid_ = threadIdx.x; asm volatile("" : "+v"(tid_));
    const int tid = tid_, wid = __builtin_amdgcn_readfirstlane(tid >> 6), lane = tid & 63, wr = wid >> 2, wc = wid & 3, fr = lane & 15, fq = lane >> 4;
    const int K = g.K, nt = K / BK, LDA = g.ldA, LDB = g.ldB;
    unsigned voffA[2], voffB[2];
#pragma unroll
    for (int i = 0; i < 2; ++i) { int R, C; stage_rc(tid * 16 + i * 8192, R, C); const int Rb = Epi::PERM ? ((R & ~31) + perm32(R & 31)) : R;
        voffA[i] = (unsigned)(R * LDA + C) * 2u; voffB[i] = (unsigned)(Rb * LDB + C) * 2u; }
    const size_t kstepA = g.kstepA, kstepB = g.kstepB;
    const size_t hstepA = (size_t)HALF * LDA * 2, hstepB = (size_t)HALF * LDB * 2;
    const size_t tstepA = 2 * hstepA, tstepB = 2 * hstepB;
    const unsigned ldsw = (unsigned)wid * 1024u;
    const int aoff = lds_byte(wr * 64 + fr, fq * 8), boff = lds_byte(wc * 32 + fr, fq * 8);
#define PG8_SA(b, h) (((b) * 2 + (h)) * HTB)
#define PG8_SB(b, h) ((4 + (b) * 2 + (h)) * HTB)
#define PG8_STAGE(bufoff, gbase, voff) do { _Pragma("unroll") for (int _i = 0; _i < 2; ++_i) \
        __builtin_amdgcn_global_load_lds((const unsigned*)((const char*)(gbase) + (voff)[_i]), (LAS unsigned*)(lds + (bufoff) + ldsw + _i * 8192), 16, 0, 0); } while (0)
#define PG8_LDA(dst, b, h) do { _Pragma("unroll") for (int m = 0; m < 4; ++m) _Pragma("unroll") for (int k = 0; k < 2; ++k) dst[m][k] = *(const LAS bf16x8*)(lds + PG8_SA(b, h) + aoff + m * 2048 + k * 1024); } while (0)
#define PG8_LDB(dst, b, h) do { _Pragma("unroll") for (int n = 0; n < 2; ++n) _Pragma("unroll") for (int k = 0; k < 2; ++k) dst[n][k] = *(const LAS bf16x8*)(lds + PG8_SB(b, h) + boff + n * 2048 + k * 1024); } while (0)
#define PG8_MMA(ai, bj, At, Bt) do { __builtin_amdgcn_s_setprio(1); _Pragma("unroll") for (int m = 0; m < 4; ++m) _Pragma("unroll") for (int n = 0; n < 2; ++n) _Pragma("unroll") for (int k = 0; k < 2; ++k) \
        acc[ai][bj][m][n] = __builtin_amdgcn_mfma_f32_16x16x32_bf16(Bt[n][k], At[m][k], acc[ai][bj][m][n], 0, 0, 0); __builtin_amdgcn_s_setprio(0); } while (0)
#define PG8_WAIT_V(n) asm volatile("s_waitcnt vmcnt(" #n ")" ::: "memory")
#define PG8_WAIT_L(n) asm volatile("s_waitcnt lgkmcnt(" #n ")" ::: "memory")
#define PG8_BAR __builtin_amdgcn_s_barrier()
#define PG8_SCHED __builtin_amdgcn_sched_barrier(0)
    Unit cur, nxt; int ui = 0;
    if (!S.next(0, cur)) return;
    cur.i = 0;
    f32x4 acc[2][2][4][2];
    E.init(acc, cur, wr, wc, fr, fq);
    bf16x8 At[4][2], B0[2][2], B1[2][2];
    const size_t ksliceA = (size_t)nt * g.kstepA, ksliceB = (size_t)nt * g.kstepB;
    const char* cA = (const char*)g.A + (size_t)cur.pm * tstepA + (g.splitk ? cur.pn * ksliceA : 0); const char* cB = (const char*)g.Bt + (g.splitk ? cur.pn * ksliceB : (size_t)cur.pn * tstepB);
    S.a_ready(cur);
    if constexpr (SP2) {
        PG8_STAGE(PG8_SB(0, 0), cB, voffB); PG8_STAGE(PG8_SB(0, 1), cB + hstepB, voffB); PG8_STAGE(PG8_SA(0, 0), cA, voffA); PG8_STAGE(PG8_SA(0, 1), cA + hstepA, voffA);
        if (wr == 1) PG8_BAR;
        PG8_WAIT_V(2); PG8_BAR;
        PG8_STAGE(PG8_SB(1, 0), cB + kstepB, voffB); PG8_STAGE(PG8_SA(1, 0), cA + kstepA, voffA); PG8_STAGE(PG8_SB(1, 1), cB + hstepB + kstepB, voffB);
        PG8_WAIT_V(6); PG8_BAR;
    } else {
        PG8_STAGE(PG8_SB(0, 0), cB, voffB); PG8_STAGE(PG8_SA(0, 0), cA, voffA); PG8_STAGE(PG8_SB(0, 1), cB + hstepB, voffB); PG8_STAGE(PG8_SA(0, 1), cA + hstepA, voffA);
        if (wr == 1) PG8_BAR;
        PG8_WAIT_V(4); PG8_BAR;
        PG8_STAGE(PG8_SB(1, 0), cB + kstepB, voffB); PG8_STAGE(PG8_SA(1, 0), cA + kstepA, voffA); PG8_STAGE(PG8_SB(1, 1), cB + hstepB + kstepB, voffB);
        PG8_WAIT_V(6); PG8_BAR;
    }
    for (;;) {
        const bool has_next = S.next(ui + 1, nxt);
        nxt.i = ui + 1;
        const char* nA = has_next ? (const char*)g.A + (size_t)nxt.pm * tstepA + (g.splitk ? nxt.pn * ksliceA : 0) : cA; const char* nB = has_next ? (const char*)g.Bt + (g.splitk ? nxt.pn * ksliceB : (size_t)nxt.pn * tstepB) : cB;
        for (int t = 0; t < nt; t += 2) {
            const bool last = (t == nt - 2);
            const char* a1 = cA + (size_t)(t + 1) * kstepA;
            const char* a2 = last ? nA : cA + (size_t)(t + 2) * kstepA; const char* b2 = last ? nB : cB + (size_t)(t + 2) * kstepB;
            const char* a3 = a2 + kstepA; const char* b3 = b2 + kstepB;
            if (last && has_next) S.a_ready(nxt);
            if constexpr (SP2) {
            PG8_LDB(B0, 0, 0); PG8_LDB(B1, 0, 1); PG8_SCHED; PG8_LDA(At, 0, 0); PG8_STAGE(PG8_SA(1, 1), a1 + hstepA, voffA);
            PG8_WAIT_V(8); PG8_WAIT_L(0); PG8_BAR; PG8_MMA(0, 0, At, B0); PG8_MMA(0, 1, At, B1); PG8_BAR; PG8_SCHED;
            PG8_LDA(At, 0, 1); PG8_STAGE(PG8_SB(0, 0), b2, voffB); PG8_STAGE(PG8_SB(0, 1), b2 + hstepB, voffB); PG8_STAGE(PG8_SA(0, 0), a2, voffA);
            PG8_WAIT_V(8); PG8_WAIT_L(0); PG8_BAR; PG8_MMA(1, 0, At, B0); PG8_MMA(1, 1, At, B1); PG8_BAR; PG8_SCHED;
            PG8_LDB(B0, 1, 0); PG8_LDB(B1, 1, 1); PG8_SCHED; PG8_LDA(At, 1, 0); PG8_STAGE(PG8_SA(0, 1), a2 + hstepA, voffA);
            PG8_WAIT_V(8); PG8_WAIT_L(0); PG8_BAR; PG8_MMA(0, 0, At, B0); PG8_MMA(0, 1, At, B1); PG8_BAR; PG8_SCHED;
            PG8_LDA(At, 1, 1); PG8_STAGE(PG8_SB(1, 0), b3, voffB); PG8_STAGE(PG8_SB(1, 1), b3 + hstepB, voffB); PG8_STAGE(PG8_SA(1, 0), a3, voffA);
            PG8_WAIT_V(8); PG8_WAIT_L(0); PG8_BAR; PG8_MMA(1, 0, At, B0); PG8_MMA(1, 1, At, B1); PG8_BAR; PG8_SCHED;
            } else {
            PG8_LDB(B0, 0, 0); PG8_SCHED; PG8_LDA(At, 0, 0); PG8_STAGE(PG8_SA(1, 1), a1 + hstepA, voffA);
            PG8_WAIT_L(8); PG8_BAR; PG8_WAIT_L(0); PG8_MMA(0, 0, At, B0); PG8_BAR; PG8_SCHED;
            PG8_LDB(B1, 0, 1); PG8_STAGE(PG8_SB(0, 0), b2, voffB);
            PG8_BAR; PG8_WAIT_L(0); PG8_MMA(0, 1, At, B1); PG8_BAR;
            PG8_LDA(At, 0, 1); PG8_STAGE(PG8_SA(0, 0), a2, voffA);
            PG8_BAR; PG8_WAIT_L(0); PG8_MMA(1, 0, At, B0); PG8_BAR; PG8_SCHED;
            PG8_STAGE(PG8_SB(0, 1), b2 + hstepB, voffB);
            PG8_WAIT_V(6); PG8_BAR; PG8_MMA(1, 1, At, B1); PG8_BAR;
            PG8_LDB(B0, 1, 0); PG8_SCHED; PG8_LDA(At, 1, 0); PG8_STAGE(PG8_SA(0, 1), a2 + hstepA, voffA);
            PG8_WAIT_L(8); PG8_BAR; PG8_WAIT_L(0); PG8_MMA(0, 0, At, B0); PG8_BAR; PG8_SCHED;
            PG8_LDB(B1, 1, 1); PG8_STAGE(PG8_SB(1, 0), b3, voffB);
            PG8_BAR; PG8_WAIT_L(0); PG8_MMA(0, 1, At, B1); PG8_BAR;
            PG8_LDA(At, 1, 1); PG8_STAGE(PG8_SA(1, 0), a3, voffA);
            PG8_BAR; PG8_WAIT_L(0); PG8_MMA(1, 0, At, B0); PG8_BAR; PG8_SCHED;
            PG8_STAGE(PG8_SB(1, 1), b3 + hstepB, voffB);
            PG8_WAIT_V(6); PG8_BAR; PG8_MMA(1, 1, At, B1); PG8_BAR;
            }
        }
        if constexpr (ALIGN_EPI) { if (wr == 0) PG8_BAR; }
        E(acc, cur, wr, wc, fr, fq);
        if (!has_next) break;
        E.init(acc, nxt, wr, wc, fr, fq);
        cur = nxt; cA = nA; cB = nB; ++ui;
        if constexpr (ALIGN_EPI) { if (wr == 1) PG8_BAR; }
    }
    PG8_WAIT_V(0);
    if constexpr (!ALIGN_EPI) { if (wr == 0) PG8_BAR; }
    PG8_BAR;
#undef PG8_SA
#undef PG8_SB
#undef PG8_STAGE
#undef PG8_LDA
#undef PG8_LDB
#undef PG8_MMA
#undef PG8_WAIT_V
#undef PG8_WAIT_L
#undef PG8_BAR
#undef PG8_SCHED
}
}
using pg8::Unit;

typedef f32x4 AccT[2][2][4][2];

__device__ __forceinline__ void rope8(f32x4& v0, f32x4& v1, const f32x2* tab_) {
    const GAS f32x2* tab = (const GAS f32x2*)tab_;
    f32x2 c0 = tab[0], c1 = tab[1], c2 = tab[2], c3 = tab[3];
    float a, b;
    a = v0[0]; b = v0[1]; v0[0] = a * c0.x - b * c0.y; v0[1] = a * c0.y + b * c0.x;
    a = v0[2]; b = v0[3]; v0[2] = a * c1.x - b * c1.y; v0[3] = a * c1.y + b * c1.x;
    a = v1[0]; b = v1[1]; v1[0] = a * c2.x - b * c2.y; v1[1] = a * c2.y + b * c2.x;
    a = v1[2]; b = v1[3]; v1[2] = a * c3.x - b * c3.y; v1[3] = a * c3.y + b * c3.x;
}


typedef f32x4 AccT_[2][2][4][2];
__device__ __forceinline__ void acc_zero(AccT_& acc) {
#pragma unroll
    for (int a = 0; a < 2; ++a)
#pragma unroll
        for (int b = 0; b < 2; ++b)
#pragma unroll
            for (int m = 0; m < 4; ++m)
#pragma unroll
                for (int n = 0; n < 2; ++n) acc[a][b][m][n] = (f32x4){0.f, 0.f, 0.f, 0.f};
}
constexpr int RSTD_LDS_OFF = 131072;
template <int NS>
__device__ __forceinline__ void fill_rstd(LAS unsigned char* lds, const float* ss, float invn, const pg8::StaticOrder& S) {
    int tid = threadIdx.x; asm volatile("" : "+v"(tid));
    LAS float* dst = (LAS float*)(lds + RSTD_LDS_OFF);
    if (tid < 256) {
        float sum[4]; bool have[4];
#pragma unroll
        for (int i = 0; i < 4; ++i) {
            Unit u; have[i] = S.next(i, u); sum[i] = 0.f;
            if (have[i]) {
                const float* q = ss + (size_t)(u.pm * 256 + tid) * NS;
#pragma unroll
                for (int k = 0; k < NS; k += 4) { const f32x4 v = *(const GAS f32x4*)(q + k); sum[i] += (v[0] + v[1]) + (v[2] + v[3]); }
            }
        }
#pragma unroll
        for (int i = 0; i < 4; ++i) if (have[i]) dst[i * 256 + tid] = rsqrtf(sum[i] * invn + EPS);
    }
    __syncthreads();
}
__device__ __forceinline__ float lds_rstd(int ui, int r) { return *(const LAS float*)((LAS unsigned char*)nullptr + RSTD_LDS_OFF + (ui * 256 + r) * 4); }

__device__ __forceinline__ void rope8_calc(f32x4& v0, f32x4& v1, float posf, const float (&inv)[4]) {
    float c[4], s[4];
#pragma unroll
    for (int p2 = 0; p2 < 4; ++p2) { const float rev = __builtin_amdgcn_fractf(posf * inv[p2]); s[p2] = __builtin_amdgcn_sinf(rev); c[p2] = __builtin_amdgcn_cosf(rev); }
    float a, b;
    a = v0[0]; b = v0[1]; v0[0] = a * c[0] - b * s[0]; v0[1] = a * s[0] + b * c[0];
    a = v0[2]; b = v0[3]; v0[2] = a * c[1] - b * s[1]; v0[3] = a * s[1] + b * c[1];
    a = v1[0]; b = v1[1]; v1[0] = a * c[2] - b * s[2]; v1[1] = a * s[2] + b * c[2];
    a = v1[2]; b = v1[3]; v1[2] = a * c[3] - b * s[3]; v1[3] = a * s[3] + b * c[3];
}
__device__ __forceinline__ void rope_inv4(int i0, float rhalf, float (&inv)[4]) {
#pragma unroll
    for (int p2 = 0; p2 < 4; ++p2) inv[p2] = __builtin_amdgcn_exp2f(-(float)(i0 + p2) * (13.287712379549449f * rhalf)) * 0.15915494309189535f;
}

__device__ __forceinline__ size_t hm_off(size_t tok, int head) { return ((tok >> 11) * 16 + (size_t)head) * (size_t)(SEQ * 128) + (tok & (SEQ - 1)) * 128; }
constexpr size_t HM_TENSOR = (size_t)T * 2048;
__device__ __forceinline__ size_t xb_off(int row, int c) { return ((size_t)(c >> 6) * T + row) * 64 + (c & 63); }

struct EpiIn {
    static constexpr bool PERM = true;
    __device__ __forceinline__ void init(AccT_& acc, const Unit&, int, int, int, int) const { acc_zero(acc); }
    const float* ssx; bf16_t* cq; bf16_t* ckv; float* mraw; bf16_t* mv; bf16_t* mo; bf16_t* krope; float* gates; float* sscq; float* ssckv; const f32x2* ropeA;
    __device__ __forceinline__ void operator()(const AccT& acc, const Unit& u, int wr, int wc, int fr, int fq) const {
        asm volatile("" : "+v"(fr), "+v"(fq));
        const int pn = u.pn;
#pragma unroll
        for (int ai = 0; ai < 2; ++ai)
#pragma unroll
            for (int m = 0; m < 4; ++m) {
                asm volatile("" ::: "memory");
                const int row = u.pm * 256 + ai * 128 + wr * 64 + m * 16 + fr;
                const float rs = lds_rstd(u.i, ai * 128 + wr * 64 + m * 16 + fr);
                float ssq = 0.f;
#pragma unroll
                for (int bj = 0; bj < 2; ++bj) {
                    const int cl = bj * 128 + wc * 32 + fq * 8;
                    f32x4 v0 = acc[ai][bj][m][0] * rs, v1 = acc[ai][bj][m][1] * rs;
                    if (pn < 4) {
                        bf16_t* dst = (pn < 2 ? cq : ckv) + xb_off(row, (pn & 1) * 256 + cl);
                        *(GAS u32x4*)dst = pk8(v0, v1);
                        ssq += (v0[0] * v0[0] + v0[1] * v0[1]) + (v0[2] * v0[2] + v0[3] * v0[3]) + (v1[0] * v1[0] + v1[1] * v1[1]) + (v1[2] * v1[2] + v1[3] * v1[3]);
                    } else if (pn < 8) {
                        float* dst = mraw + (size_t)row * 1024 + (pn - 4) * 256 + cl;
                        *(GAS f32x4*)dst = v0; *(GAS f32x4*)(dst + 4) = v1;
                    } else if (pn < 12) {
                        *(GAS u32x4*)(mv + (size_t)row * 1024 + (pn - 8) * 256 + cl) = pk8(v0, v1);
                    } else if (pn < 16) {
#pragma unroll
                        for (int e = 0; e < 4; ++e) { v0[e] = sigmoidf_(v0[e]); v1[e] = sigmoidf_(v1[e]); }
                        *(GAS u32x4*)(mo + (size_t)row * 1024 + (pn - 12) * 256 + cl) = pk8(v0, v1);
                    } else {
                        if (bj == 0) {
                            if (wc < 2) {
                                const int pos = row & (SEQ - 1);
                                rope8(v0, v1, ropeA + pos * 32 + (cl >> 1));
                                *(GAS u32x4*)(krope + (size_t)row * 64 + cl) = pk8(v0, v1);
                            } else if (wc == 2 && fq == 0) {
                                *(GAS f32x4*)(gates + (size_t)row * 8) = v0; *(GAS f32x4*)(gates + (size_t)row * 8 + 4) = v1;
                            }
                        }
                    }
                }
                if (pn < 4) {
                    ssq += __shfl_xor(ssq, 16); ssq += __shfl_xor(ssq, 32);
                    if (fq == 0) *(GAS float*)((pn < 2 ? sscq : ssckv) + (size_t)row * 8 + (pn & 1) * 4 + wc) = ssq;
                }
            }
    }
};

struct EpiUQ {
    static constexpr bool PERM = true;
    __device__ __forceinline__ void init(AccT_& acc, const Unit&, int, int, int, int) const { acc_zero(acc); }
    const float* sscq; bf16_t* qb; const f32x2* ropeA;
    __device__ __forceinline__ void operator()(const AccT& acc, const Unit& u, int wr, int wc, int fr, int fq) const {
        asm volatile("" : "+v"(fr), "+v"(fq));
        const int pn = u.pn;
        const float qs = 0.07216878364870322f * LOG2E;
        float inv[2][4];
#pragma unroll
        for (int bj = 0; bj < 2; ++bj) rope_inv4(((bj * 128 + wc * 32 + fq * 8) & 63) >> 1, 1.0f / 32.0f, inv[bj]);
#pragma unroll
        for (int ai = 0; ai < 2; ++ai)
#pragma unroll
            for (int m = 0; m < 4; ++m) {
                asm volatile("" ::: "memory");
                const int row = u.pm * 256 + ai * 128 + wr * 64 + m * 16 + fr;
                const float rs = lds_rstd(u.i, ai * 128 + wr * 64 + m * 16 + fr) * qs;
#pragma unroll
                for (int bj = 0; bj < 2; ++bj) {
                    const int cl = bj * 128 + wc * 32 + fq * 8;
                    f32x4 v0 = acc[ai][bj][m][0] * rs, v1 = acc[ai][bj][m][1] * rs;
                    if (pn < 4) {
                        *(GAS u32x4*)(qb + (size_t)row * 1536 + pn * 256 + cl) = pk8(v0, v1);
                    } else {
                        const int cr = (pn - 4) * 256 + cl;
                        rope8_calc(v0, v1, (float)(row & (SEQ - 1)), inv[bj]);
                        *(GAS u32x4*)(qb + (size_t)row * 1536 + 1024 + cr) = pk8(v0, v1);
                    }
                }
            }
    }
};

struct EpiUKV {
    static constexpr bool PERM = true;
    __device__ __forceinline__ void init(AccT_& acc, const Unit&, int, int, int, int) const { acc_zero(acc); }
    const float* ssckv; bf16_t* knope; bf16_t* vb;
    __device__ __forceinline__ void operator()(const AccT& acc, const Unit& u, int wr, int wc, int fr, int fq) const {
        asm volatile("" : "+v"(fr), "+v"(fq));
        const int pn = u.pn;
#pragma unroll
        for (int ai = 0; ai < 2; ++ai)
#pragma unroll
            for (int m = 0; m < 4; ++m) {
                asm volatile("" ::: "memory");
                const int row = u.pm * 256 + ai * 128 + wr * 64 + m * 16 + fr;
                const float rs = lds_rstd(u.i, ai * 128 + wr * 64 + m * 16 + fr);
#pragma unroll
                for (int bj = 0; bj < 2; ++bj) {
                    const int cl = bj * 128 + wc * 32 + fq * 8;
                    f32x4 v0 = acc[ai][bj][m][0] * rs, v1 = acc[ai][bj][m][1] * rs;
                    bf16_t* dst = (pn < 4 ? knope + (size_t)row * 1024 + pn * 256 : vb + (size_t)row * 1024 + (pn - 4) * 256) + cl;
                    *(GAS u32x4*)dst = pk8(v0, v1);
                }
            }
    }
};

struct EpiQKV {
    static constexpr bool PERM = true;
    __device__ __forceinline__ void init(AccT_& acc, const Unit&, int, int, int, int) const { acc_zero(acc); }
    const float* ssx; bf16_t* qkv; const f32x2* ropeB;
    __device__ __forceinline__ void operator()(const AccT& acc, const Unit& u, int wr, int wc, int fr, int fq) const {
        asm volatile("" : "+v"(fr), "+v"(fq));
        const int pn = u.pn;
        const float qs = 0.08838834764831845f * LOG2E;
        float inv[2][4];
#pragma unroll
        for (int bj = 0; bj < 2; ++bj) rope_inv4(((bj * 128 + wc * 32 + fq * 8) & 127) >> 1, 1.0f / 64.0f, inv[bj]);
#pragma unroll
        for (int ai = 0; ai < 2; ++ai)
#pragma unroll
            for (int m = 0; m < 4; ++m) {
                asm volatile("" ::: "memory");
                const int row = u.pm * 256 + ai * 128 + wr * 64 + m * 16 + fr;
                float rs = lds_rstd(u.i, ai * 128 + wr * 64 + m * 16 + fr);
                if (pn < 8) rs *= qs;
#pragma unroll
                for (int bj = 0; bj < 2; ++bj) {
                    const int cl = bj * 128 + wc * 32 + fq * 8, c = pn * 256 + cl;
                    f32x4 v0 = acc[ai][bj][m][0] * rs, v1 = acc[ai][bj][m][1] * rs;
                    if (pn < 16) rope8_calc(v0, v1, (float)(row & (SEQ - 1)), inv[bj]);
                    *(GAS u32x4*)(qkv + (size_t)(c >> 11) * HM_TENSOR + hm_off((size_t)row, (c & 2047) >> 7) + (c & 127)) = pk8(v0, v1);
                }
            }
    }
};

struct EpiRes {
    static constexpr bool PERM = true;
    bf16_t* xb; float* ssx;
    __device__ __forceinline__ void init(AccT_& acc, const Unit& u, int wr, int wc, int fr, int fq) const {
        asm volatile("" : "+v"(fr), "+v"(fq));
#pragma unroll
        for (int ai = 0; ai < 2; ++ai)
#pragma unroll
            for (int m = 0; m < 4; ++m)
#pragma unroll
                for (int bj = 0; bj < 2; ++bj) {
                    const u32x4 w = *(const GAS u32x4*)(xb + xb_off(u.pm * 256 + ai * 128 + wr * 64 + m * 16 + fr, u.pn * 256 + bj * 128 + wc * 32 + fq * 8));
                    acc[ai][bj][m][0] = (f32x4){bflo(w.x), bfhi(w.x), bflo(w.y), bfhi(w.y)}; acc[ai][bj][m][1] = (f32x4){bflo(w.z), bfhi(w.z), bflo(w.w), bfhi(w.w)};
                }
    }
    __device__ __forceinline__ void operator()(const AccT& acc, const Unit& u, int wr, int wc, int fr, int fq) const {
        asm volatile("" : "+v"(fr), "+v"(fq));
        const int pn = u.pn;
#pragma unroll
        for (int ai = 0; ai < 2; ++ai)
#pragma unroll
            for (int m = 0; m < 4; ++m) {
                asm volatile("" ::: "memory");
                const int row = u.pm * 256 + ai * 128 + wr * 64 + m * 16 + fr;
                float ssq = 0.f;
#pragma unroll
                for (int bj = 0; bj < 2; ++bj) {
                    const int c = pn * 256 + bj * 128 + wc * 32 + fq * 8;
                    const u32x4 w = pk8(acc[ai][bj][m][0], acc[ai][bj][m][1]);
                    *(GAS u32x4*)(xb + xb_off(row, c)) = w;
                    const float a0 = bflo(w.x), a1 = bfhi(w.x), a2 = bflo(w.y), a3 = bfhi(w.y), a4 = bflo(w.z), a5 = bfhi(w.z), a6 = bflo(w.w), a7 = bfhi(w.w);
                    ssq += (a0 * a0 + a1 * a1) + (a2 * a2 + a3 * a3) + (a4 * a4 + a5 * a5) + (a6 * a6 + a7 * a7);
                }
                ssq += __shfl_xor(ssq, 16); ssq += __shfl_xor(ssq, 32);
                if (fq == 0) *(GAS float*)(ssx + (size_t)row * 32 + pn * 4 + wc) = ssq;
            }
    }
};

struct EpiRelu2 {
    static constexpr bool PERM = true;
    __device__ __forceinline__ void init(AccT_& acc, const Unit&, int, int, int, int) const { acc_zero(acc); }
    const float* ssx; bf16_t* ub;
    __device__ __forceinline__ void operator()(const AccT& acc, const Unit& u, int wr, int wc, int fr, int fq) const {
        asm volatile("" : "+v"(fr), "+v"(fq));
        const int pn = u.pn;
#pragma unroll
        for (int ai = 0; ai < 2; ++ai)
#pragma unroll
            for (int m = 0; m < 4; ++m) {
                asm volatile("" ::: "memory");
                const int row = u.pm * 256 + ai * 128 + wr * 64 + m * 16 + fr;
                const float rs = lds_rstd(u.i, ai * 128 + wr * 64 + m * 16 + fr);
#pragma unroll
                for (int bj = 0; bj < 2; ++bj) {
                    const int c = pn * 256 + bj * 128 + wc * 32 + fq * 8;
                    f32x4 v0 = acc[ai][bj][m][0] * rs, v1 = acc[ai][bj][m][1] * rs;
#pragma unroll
                    for (int e = 0; e < 4; ++e) { float a = fmaxf(v0[e], 0.f), b = fmaxf(v1[e], 0.f); v0[e] = a * a; v1[e] = b * b; }
                    *(GAS u32x4*)(ub + ((size_t)(c >> 6) * T + row) * 64 + (c & 63)) = pk8(v0, v1);
                }
            }
    }
};

template <int NS, class Epi>
__device__ __forceinline__ void run_gemm(LAS unsigned char* lds, const bf16_t* A, const bf16_t* Bt, int N, int K, const Epi& E, const float* ss = nullptr, bool kblocked = false, int wrows_ = 0) {
    const int wrows = wrows_ ? wrows_ : N;
    pg8::Gemm g; g.A = A; g.Bt = Bt; g.M = T; g.N = N; g.K = K; g.splitk = 0;
    g.ldB = 64; g.kstepB = (size_t)wrows * 128;
    g.ldA = K; g.kstepA = 128;
    if (kblocked) { g.ldA = 64; g.kstepA = (size_t)T * 128; }
    int cblk = (int)blockIdx.x; asm volatile("" : "+s"(cblk));
    pg8::StaticOrder S; S.init(T, N, (int)gridDim.x, cblk);
    if constexpr (NS > 0) fill_rstd<NS>(lds, ss, NS == 32 ? 1.0f / 2048.0f : 1.0f / 512.0f, S);
    pg8::gemm_phase<Epi, pg8::StaticOrder, true, true>(lds, g, S, E);
}

struct EpiPart {
    static constexpr bool PERM = true;
    float* part;
    __device__ __forceinline__ void init(AccT_& acc, const Unit&, int, int, int, int) const { acc_zero(acc); }
    __device__ __forceinline__ void operator()(const AccT& acc, const Unit& u, int wr, int wc, int fr, int fq) const {
        asm volatile("" : "+v"(fr), "+v"(fq));
        const int cl = wc * 32 + fq * 8;
        if (cl < 72) {
#pragma unroll
            for (int ai = 0; ai < 2; ++ai)
#pragma unroll
                for (int m = 0; m < 4; ++m) {
                    const int row = u.pm * 256 + ai * 128 + wr * 64 + m * 16 + fr;
                    float* dst = part + ((size_t)u.pn * T + row) * 72 + cl;
                    *(GAS f32x4*)dst = acc[ai][0][m][0]; *(GAS f32x4*)(dst + 4) = acc[ai][0][m][1];
                }
        }
    }
};
__device__ __forceinline__ void run_gemm_splitk(LAS unsigned char* lds, const bf16_t* A, const bf16_t* Bt_tile, const EpiPart& E) {
    pg8::Gemm g; g.A = A; g.Bt = Bt_tile; g.M = T; g.N = 2048; g.K = 256; g.splitk = 1; g.ldA = 64; g.kstepA = (size_t)T * 128; g.ldB = 64; g.kstepB = (size_t)NIN * 128;
    int cblk = (int)blockIdx.x; asm volatile("" : "+s"(cblk));
    pg8::StaticOrder S; S.init(T, 2048, (int)gridDim.x, cblk);
    pg8::gemm_phase<EpiPart, pg8::StaticOrder, true, true>(lds, g, S, E);
}

__device__ __forceinline__ int dstmap(int id, int n) {
    switch (id) {
    case 1:
        if (n < 1024) return n;
        if (n < 1088) { const int r = n - 1024; return 4096 + (r < 32 ? 2 * r : 2 * (r - 32) + 1); }
        if (n < 2112) return 1024 + (n - 1088);
        if (n < 3136) return 2048 + (n - 2112);
        if (n < 3140) return 4160 + (n - 3136);
        if (n < 3144) return 4164 + (n - 3140);
        return 3072 + (n - 3144);
    case 2: { const int h = n / 192, d = n - h * 192; if (d < 128) return h * 128 + d; const int r = d - 128; return 1024 + h * 64 + (r < 32 ? 2 * r : 2 * (r - 32) + 1); }
    case 3: { const int h = n >> 8, e = n & 255; return (e < 128) ? h * 128 + e : 1024 + h * 128 + (e - 128); }
    case 4:
        if (n < 4096) { const int base = n & ~127, d = n & 127; return base + (d < 64 ? 2 * d : 2 * (d - 64) + 1); }
        return n;
    default: return n;
    }
}
__device__ __forceinline__ void prep_transpose(const float* W, int K, int Nsrc, int mapid, const float* gain, bf16_t* WT, LAS float* scr, int gw, int ngw, int lane, int blocked_rows = 0) {
    const int nblk = (Nsrc + 63) / 64, nitems = (K / 64) * nblk;
    const int q = lane & 15, r4 = lane >> 4;
    for (int it = gw; it < nitems; it += ngw) {
        const int kb = it / nblk, nb = it % nblk, k0 = 64 * kb, n0 = 64 * nb;
        const int ncol = n0 + 4 * q; const bool ok = ncol < Nsrc;
        f32x4 v[16];
#pragma unroll
        for (int i = 0; i < 16; ++i) v[i] = ok ? *(const GAS f32x4*)(W + (size_t)(k0 + 4 * i + r4) * Nsrc + ncol) : (f32x4){0.f, 0.f, 0.f, 0.f};
#pragma unroll
        for (int i = 0; i < 16; ++i) {
            const float g = gain ? gain[k0 + 4 * i + r4] : 1.0f;
            LAS float* d = scr + (4 * i + r4) * 65 + 4 * q;
            d[0] = v[i][0] * g; d[1] = v[i][1] * g; d[2] = v[i][2] * g; d[3] = v[i][3] * g;
        }
        asm volatile("s_waitcnt lgkmcnt(0)" ::: "memory");
        const int c = lane & 7;
#pragma unroll
        for (int j = 0; j < 8; ++j) {
            const int n = (lane >> 3) + 8 * j; const LAS float* s = scr + (8 * c) * 65 + n;
            u32x4 o; o.x = pk2(s[0 * 65], s[1 * 65]); o.y = pk2(s[2 * 65], s[3 * 65]); o.z = pk2(s[4 * 65], s[5 * 65]); o.w = pk2(s[6 * 65], s[7 * 65]);
            if (n0 + n < Nsrc) {
                const int dn = dstmap(mapid, n0 + n);
                bf16_t* dp = blocked_rows ? WT + ((size_t)(k0 >> 6) * blocked_rows + dn) * 64 + 8 * c : WT + (size_t)dn * K + k0 + 8 * c;
                *(GAS u32x4*)dp = o;
            }
        }
        asm volatile("s_waitcnt lgkmcnt(0)" ::: "memory");
    }
}

__device__ __forceinline__ void phase_prep(const Params& p, LAS unsigned char* lds) {
    const int tid = threadIdx.x, wave = tid >> 6, lane = tid & 63;
    const int gw = blockIdx.x * 8 + wave, ngw = gridDim.x * 8;
    LAS float* scr = (LAS float*)(lds + wave * 16640);
    unsigned char* ws = opaque_ws(p);
    for (int row = gw; row < T; row += ngw) {
        const GAS f32x4* xr = (const GAS f32x4*)(p.x + (size_t)row * DM) + lane;
        bf16_t* xbase = (bf16_t*)(ws + OFF_XB);
        float s = 0.f;
#pragma unroll
        for (int j = 0; j < 8; ++j) { f32x4 v = xr[64 * j]; u32x2 o; o.x = pk2(v[0], v[1]); o.y = pk2(v[2], v[3]); *(GAS u32x2*)(xbase + xb_off(row, 4 * (lane + 64 * j))) = o; const float a0 = bflo(o.x), a1 = bfhi(o.x), a2 = bflo(o.y), a3 = bfhi(o.y); s += (a0 * a0 + a1 * a1) + (a2 * a2 + a3 * a3); }
        s = wave_sum(s);
        if (lane < 32) ((GAS float*)(ws + OFF_SSX))[(size_t)row * 32 + lane] = (lane == 0) ? s : 0.f;
    }
    for (int l = 0; l < 2; ++l) {
        prep_transpose(p.ev_w_in + (size_t)l * 2048 * 4168, 2048, 4168, 1, p.norm_mix + (size_t)(2 * l) * DM, (bf16_t*)(ws + OFF_WIN + l * SZ_WIN), scr, gw, ngw, lane, NIN);
        prep_transpose(p.mla_w_uq + (size_t)l * 512 * 1536, 512, 1536, 2, p.mla_q_norm + l * 512, (bf16_t*)(ws + OFF_WUQ + l * SZ_WUQ), scr, gw, ngw, lane, 1536);
        prep_transpose(p.mla_w_ukv + (size_t)l * 512 * 2048, 512, 2048, 3, p.mla_kv_norm + l * 512, (bf16_t*)(ws + OFF_WUKV + l * SZ_WUKV), scr, gw, ngw, lane, 2048);
        prep_transpose(p.ev_w_out + (size_t)l * 2048 * 2048, 2048, 2048, 0, nullptr, (bf16_t*)(ws + OFF_WEVO + l * SZ_WO), scr, gw, ngw, lane, 2048);
        prep_transpose(p.od_w_qkv + (size_t)l * 2048 * 6144, 2048, 6144, 4, p.norm_mix + (size_t)(2 * l + 1) * DM, (bf16_t*)(ws + OFF_WQKV + l * SZ_WQKV), scr, gw, ngw, lane, 6144);
        prep_transpose(p.od_w_out + (size_t)l * 2048 * 2048, 2048, 2048, 0, nullptr, (bf16_t*)(ws + OFF_WODO + l * SZ_WO), scr, gw, ngw, lane, 2048);
    }
    for (int l = 0; l < 4; ++l) {
        prep_transpose(p.mlp_w1 + (size_t)l * 2048 * 8192, 2048, 8192, 0, p.norm_mlp + (size_t)l * DM, (bf16_t*)(ws + OFF_W1 + l * SZ_W1), scr, gw, ngw, lane, 8192);
        prep_transpose(p.mlp_w2 + (size_t)l * 8192 * 2048, 8192, 2048, 0, nullptr, (bf16_t*)(ws + OFF_W2 + l * SZ_W1), scr, gw, ngw, lane, 2048);
    }
}

struct AttnArgs {
    const bf16_t* q; const bf16_t* k0; const bf16_t* k1; const bf16_t* v;
    int h, tokbase, dil, qb, kt_begin, kt_end;
    bf16_t* out; int ostride, ooff; float* lse;
    int oblk;
};
template <int MODE>
__device__ __forceinline__ void attn_item(const AttnArgs& a, LAS unsigned char* lds) {
    constexpr bool MLA = (MODE == 0), TWO = (MODE == 2);
    constexpr int DQ = MLA ? 192 : 128, KST = DQ + 8, NKC = DQ / 32, VST = 144;
    constexpr int KB = 64 * KST * 2, VB = 64 * VST * 2;
    constexpr int NTH = TWO ? 256 : 512;
    constexpr int NKL = (64 * (DQ / 8)) / NTH, NVL = (64 * 16) / NTH;
    constexpr int QROWS = TWO ? 128 : 256;
    int tid = threadIdx.x; asm volatile("" : "+v"(tid));
    const int wave = __builtin_amdgcn_readfirstlane(tid >> 6), lane = tid & 63; int lq = lane & 15, quad = lane >> 4;
    const int strm = TWO ? (wave >> 2) : 0, rowbase = (TWO ? (wave & 3) : wave) * 32;
    const int stid = TWO ? (tid & 255) : tid;
    const int tokbase = a.tokbase + strm;
    LAS unsigned char* Kbuf0 = lds + strm * 2 * (KB + VB);
    const int qrow0 = a.qb * QROWS + rowbase;
    bf16x8 qf[2][NKC];
#pragma unroll
    for (int sub = 0; sub < 2; ++sub) {
        const size_t qtok = (size_t)(tokbase + (qrow0 + sub * 16 + lq) * a.dil);
#pragma unroll
        for (int kk = 0; kk < NKC; ++kk) {
            const int d0 = kk * 32 + quad * 8;
            const bf16_t* src;
            if (MLA) src = (d0 < 128) ? a.q + qtok * 1536 + a.h * 128 + d0 : a.q + qtok * 1536 + 1024 + a.h * 64 + (d0 - 128);
            else src = a.q + hm_off(qtok, a.h) + d0;
            qf[sub][kk] = *(const GAS bf16x8*)src;
        }
    }
    float m[2] = {-1e30f, -1e30f}, l[2] = {0.f, 0.f};
    f32x4 o[2][8];
#pragma unroll
    for (int sub = 0; sub < 2; ++sub)
#pragma unroll
        for (int i = 0; i < 8; ++i) o[sub][i] = (f32x4){0.f, 0.f, 0.f, 0.f};
    u32x4 kreg[NKL], vreg[NVL];
    auto prefetch = [&](int kt) {
#pragma unroll
        for (int i = 0; i < NKL; ++i) {
            const int c = stid + NTH * i;
            if (MLA) {
                const int r = c / 24, cc = c % 24; const size_t tok = (size_t)(tokbase + (kt * 64 + r) * a.dil);
                const bf16_t* src = (cc < 16) ? a.k0 + tok * 1024 + a.h * 128 + cc * 8 : a.k1 + tok * 64 + (cc - 16) * 8;
                kreg[i] = *(const GAS u32x4*)src;
            } else {
                const int r = c >> 4, cc = c & 15; const size_t tok = (size_t)(tokbase + (kt * 64 + r) * a.dil);
                kreg[i] = *(const GAS u32x4*)(a.k0 + hm_off(tok, a.h) + cc * 8);
            }
        }
#pragma unroll
        for (int i = 0; i < NVL; ++i) {
            const int c = stid + NTH * i, r = c >> 4, cc = c & 15; const size_t tok = (size_t)(tokbase + (kt * 64 + r) * a.dil);
            vreg[i] = *(const GAS u32x4*)(MLA ? a.v + tok * 1024 + a.h * 128 + cc * 8 : a.v + hm_off(tok, a.h) + cc * 8);
        }
    };
    auto stage = [&](LAS unsigned char* Kd) {
        LAS unsigned char* Vd = Kd + KB;
#pragma unroll
        for (int i = 0; i < NKL; ++i) {
            const int c = stid + NTH * i;
            const int r = MLA ? c / 24 : c >> 4, cc = MLA ? c % 24 : c & 15;
            *(LAS u32x4*)(Kd + (r * KST + cc * 8) * 2) = kreg[i];
        }
#pragma unroll
        for (int i = 0; i < NVL; ++i) { const int c = stid + NTH * i, r = c >> 4, cc = c & 15; *(LAS u32x4*)(Vd + (r * VST + cc * 8) * 2) = vreg[i]; }
    };
    prefetch(a.kt_begin);
    stage(Kbuf0);
    if (a.kt_begin + 1 < a.kt_end) prefetch(a.kt_begin + 1);
    __syncthreads();
    for (int kt = a.kt_begin; kt < a.kt_end; ++kt) {
        asm volatile("" : "+v"(lq), "+v"(quad), "+v"(tid));
        const int cur = (kt - a.kt_begin) & 1;
        LAS unsigned char* Ks = Kbuf0 + cur * (KB + VB);
        LAS unsigned char* Vs = Ks + KB;
        if (kt + 1 < a.kt_end) { stage(Kbuf0 + (cur ^ 1) * (KB + VB)); if (kt + 2 < a.kt_end) prefetch(kt + 2); }
        const int k0s = kt * 64;
        const bool dead = MLA ? (k0s > qrow0 + 31) : (k0s > qrow0 + 31 || k0s + 63 < qrow0 - 128);
        if (!dead) {
            f32x4 s[2][4];
            bf16x8 kfr[2][NKC];
            LAS unsigned char* kbase = Ks + (lq * KST + quad * 8) * 2;
#pragma unroll
            for (int kk = 0; kk < NKC; ++kk) kfr[0][kk] = *(const LAS bf16x8*)(kbase + kk * 64);
#pragma unroll
            for (int nt = 0; nt < 4; ++nt) {
                if (nt + 1 < 4) {
#pragma unroll
                    for (int kk = 0; kk < NKC; ++kk) kfr[(nt + 1) & 1][kk] = *(const LAS bf16x8*)(kbase + (nt + 1) * 16 * KST * 2 + kk * 64);
                }
                __builtin_amdgcn_sched_barrier(0);
                s[0][nt] = (f32x4){0.f, 0.f, 0.f, 0.f}; s[1][nt] = (f32x4){0.f, 0.f, 0.f, 0.f};
                __builtin_amdgcn_s_setprio(1);
#pragma unroll
                for (int kk = 0; kk < NKC; ++kk) {
                    s[0][nt] = mfma16(kfr[nt & 1][kk], qf[0][kk], s[0][nt]);
                    s[1][nt] = mfma16(kfr[nt & 1][kk], qf[1][kk], s[1][nt]);
                }
                __builtin_amdgcn_s_setprio(0);
                __builtin_amdgcn_sched_barrier(0);
            }
            bf16x8 vfr[2][4];
            LAS unsigned char* vbase = Vs + ((quad * 4 + (lq >> 2)) * VST + (lq & 3) * 4) * 2;
#pragma unroll
            for (int d4 = 0; d4 < 4; ++d4) vfr[0][d4] = mk8(lds_tr(vbase + d4 * 32), lds_tr(vbase + d4 * 32 + 16 * VST * 2));
            __builtin_amdgcn_sched_barrier(0);
            const bool needmask = MLA ? (k0s + 63 > qrow0) : true;
            bf16x8 pf[2][2];
#pragma unroll
            for (int sub = 0; sub < 2; ++sub) {
                if (needmask) {
                    const int ql = qrow0 + sub * 16 + lq;
#pragma unroll
                    for (int nt = 0; nt < 4; ++nt)
#pragma unroll
                        for (int jj = 0; jj < 4; ++jj) {
                            const int d = ql - (k0s + nt * 16 + quad * 4 + jj);
                            const bool valid = MLA ? (d >= 0) : (d >= 0 && d <= 128);
                            s[sub][nt][jj] = valid ? s[sub][nt][jj] : -1e30f;
                        }
                }
                float mx = -1e30f;
#pragma unroll
                for (int nt = 0; nt < 4; ++nt)
#pragma unroll
                    for (int jj = 0; jj < 4; ++jj) mx = fmaxf(mx, s[sub][nt][jj]);
                mx = fmaxf(mx, __shfl_xor(mx, 16)); mx = fmaxf(mx, __shfl_xor(mx, 32));
                const float mnew = fmaxf(m[sub], mx), alpha = __builtin_amdgcn_exp2f(m[sub] - mnew);
                float ps = 0.f;
#pragma unroll
                for (int nt = 0; nt < 4; ++nt)
#pragma unroll
                    for (int jj = 0; jj < 4; ++jj) { const float pv = __builtin_amdgcn_exp2f(s[sub][nt][jj] - mnew); s[sub][nt][jj] = pv; ps += pv; }
                l[sub] = l[sub] * alpha + ps; m[sub] = mnew;
#pragma unroll
                for (int i = 0; i < 8; ++i) o[sub][i] *= alpha;
#pragma unroll
                for (int k2 = 0; k2 < 2; ++k2) {
                    u32x4 w; w.x = pk2(s[sub][2 * k2][0], s[sub][2 * k2][1]); w.y = pk2(s[sub][2 * k2][2], s[sub][2 * k2][3]);
                    w.z = pk2(s[sub][2 * k2 + 1][0], s[sub][2 * k2 + 1][1]); w.w = pk2(s[sub][2 * k2 + 1][2], s[sub][2 * k2 + 1][3]);
                    pf[sub][k2] = __builtin_bit_cast(bf16x8, w);
                }
            }
            __builtin_amdgcn_sched_barrier(0);
#pragma unroll
            for (int bi = 0; bi < 4; ++bi) {
                if (bi + 1 < 4) {
                    const int k2n = (bi + 1) >> 1, dtn = ((bi + 1) & 1) * 4;
#pragma unroll
                    for (int d4 = 0; d4 < 4; ++d4) vfr[(bi + 1) & 1][d4] = mk8(lds_tr(vbase + k2n * 32 * VST * 2 + (dtn + d4) * 32), lds_tr(vbase + k2n * 32 * VST * 2 + (dtn + d4) * 32 + 16 * VST * 2));
                }
                __builtin_amdgcn_sched_barrier(0);
                const int k2 = bi >> 1, dt0 = (bi & 1) * 4;
                __builtin_amdgcn_s_setprio(1);
#pragma unroll
                for (int d4 = 0; d4 < 4; ++d4) {
                    o[0][dt0 + d4] = mfma16(vfr[bi & 1][d4], pf[0][k2], o[0][dt0 + d4]);
                    o[1][dt0 + d4] = mfma16(vfr[bi & 1][d4], pf[1][k2], o[1][dt0 + d4]);
                }
                __builtin_amdgcn_s_setprio(0);
                __builtin_amdgcn_sched_barrier(0);
            }
        }
        __syncthreads();
    }
#pragma unroll
    for (int sub = 0; sub < 2; ++sub) {
        float lt = l[sub];
        lt += __shfl_xor(lt, 16); lt += __shfl_xor(lt, 32);
        const float inv = 1.0f / lt;
        const size_t qtok = (size_t)(tokbase + (qrow0 + sub * 16 + lq) * a.dil);
        bf16_t* op = a.oblk ? a.out + xb_off((int)qtok, a.ooff) : a.out + qtok * a.ostride + a.ooff;
#pragma unroll
        for (int dt = 0; dt < 8; ++dt) {
            u32x2 w; w.x = pk2(o[sub][dt][0] * inv, o[sub][dt][1] * inv); w.y = pk2(o[sub][dt][2] * inv, o[sub][dt][3] * inv);
            *(GAS u32x2*)(op + (a.oblk ? (size_t)(dt >> 2) * T * 64 + (dt & 3) * 16 + quad * 4 : (size_t)(dt * 16 + quad * 4))) = w;
        }
        if (a.lse != nullptr && quad == 0) *(GAS float*)(a.lse + qtok * 16 + a.h) = m[sub] + __log2f(lt);
    }
}

__device__ __forceinline__ float logsigf_(float x) { return fminf(x, 0.f) - log1pf(__expf(-fabsf(x))); }

__device__ __forceinline__ void conv_silu8(const float* mraw, const float* convw, const float* convb, int b, int sp, int col, f32x4& y0, f32x4& y1) {
    y0 = *(const GAS f32x4*)(convb + col); y1 = *(const GAS f32x4*)(convb + col + 4);
#pragma unroll
    for (int jj = 0; jj < 4; ++jj) {
        const int s2 = sp - 3 + jj;
        if (s2 >= 0) {
            const float* r = mraw + (size_t)(b * SEQ + s2) * 1024 + col;
            const f32x4 x0 = *(const GAS f32x4*)r, x1 = *(const GAS f32x4*)(r + 4);
            const f32x4 w0 = *(const GAS f32x4*)(convw + jj * 1024 + col), w1 = *(const GAS f32x4*)(convw + jj * 1024 + col + 4);
            y0 += w0 * x0; y1 += w1 * x1;
        }
    }
#pragma unroll
    for (int e = 0; e < 4; ++e) { y0[e] = y0[e] * sigmoidf_(y0[e]); y1[e] = y1[e] * sigmoidf_(y1[e]); }
}

__device__ __forceinline__ void mlstm_A(const Params& p, int li, LAS unsigned char* lds, int item) {
    int tid = threadIdx.x; asm volatile("" : "+v"(tid));
    const int wave = __builtin_amdgcn_readfirstlane(tid >> 6), lane = tid & 63, lq = lane & 15, quad = lane >> 4;
    const int bh = item >> 4, c = item & 15, b = bh >> 2, h = bh & 3;
    constexpr int KPST = 144, VST = 272;
    LAS unsigned char* Kp = lds;
    LAS unsigned char* Vs = lds + 36864;
    LAS float* wkv = (LAS float*)(lds + 106496);
    unsigned char* ws = opaque_ws(p);
    const float* mraw = (const float*)(ws + OFF_MRAW);
    const bf16_t* mv = (const bf16_t*)(ws + OFF_MV);
    const float* gates = (const float*)(ws + OFF_GATES);
    bf16_t* mq = (bf16_t*)(ws + OFF_MQ); bf16_t* mk = (bf16_t*)(ws + OFF_MK);
    const float* convw = p.conv_w + (size_t)li * 4 * 1024;
    const float* convb = p.conv_b + (size_t)li * 1024;
    const float bi = p.b_i[li * 4 + h], bfv = p.b_f[li * 4 + h];
    const int tok0 = b * SEQ + c * 128;
    LAS float* gi = wkv + 128; LAS float* gf = gi + 128;
    __syncthreads();
    {
        const int row = tid >> 2, pt = tid & 3;
        const size_t tok = (size_t)(tok0 + row);
        const float* sp = (const float*)(ws + OFF_SSX) + tok * 32 + pt * 8;
        const f32x4 s0v = *(const GAS f32x4*)sp, s1v = *(const GAS f32x4*)(sp + 4);
        float ssq = ((s0v[0] + s0v[1]) + (s0v[2] + s0v[3])) + ((s1v[0] + s1v[1]) + (s1v[2] + s1v[3]));
        ssq += __shfl_xor(ssq, 1); ssq += __shfl_xor(ssq, 2);
        const float rs = rsqrtf(ssq * (1.0f / 2048.0f) + EPS);
        const float* pp = (const float*)(ws + OFF_PART) + tok * 72;
        f32x4 kv = (f32x4){0.f, 0.f, 0.f, 0.f}; float gsum = 0.f;
#pragma unroll
        for (int ks = 0; ks < 8; ++ks) {
            kv += *(const GAS f32x4*)(pp + (size_t)ks * T * 72 + 16 * h + 4 * pt);
            if (pt < 2) gsum += *(const GAS float*)(pp + (size_t)ks * T * 72 + 64 + 4 * pt + h);
        }
        kv *= rs; gsum *= rs;
        f32x2 c0, c1;
        {
            const float posf = (float)((int)tok & (SEQ - 1)), i0f = (float)(8 * h + 2 * pt);
            const float r0 = __builtin_amdgcn_fractf(posf * (__builtin_amdgcn_exp2f(-i0f * (13.287712379549449f / 32.0f)) * 0.15915494309189535f));
            const float r1 = __builtin_amdgcn_fractf(posf * (__builtin_amdgcn_exp2f(-(i0f + 1.0f) * (13.287712379549449f / 32.0f)) * 0.15915494309189535f));
            c0.x = __builtin_amdgcn_cosf(r0); c0.y = __builtin_amdgcn_sinf(r0); c1.x = __builtin_amdgcn_cosf(r1); c1.y = __builtin_amdgcn_sinf(r1);
        }
        u32x2 w2; w2.x = pk2(kv[0] * c0.x - kv[1] * c0.y, kv[0] * c0.y + kv[1] * c0.x); w2.y = pk2(kv[2] * c1.x - kv[3] * c1.y, kv[2] * c1.y + kv[3] * c1.x);
        *(GAS u32x2*)((bf16_t*)(ws + OFF_KROPE) + tok * 64 + 16 * h + 4 * pt) = w2;
        if (pt < 2) { *(GAS float*)((float*)(ws + OFF_GATES) + tok * 8 + 4 * pt + h) = gsum; (pt == 0 ? gi : gf)[row] = gsum; }
    }
    __syncthreads();
    if (wave == 0) {
        const int s0 = 2 * lane;
        const float i0 = gi[s0] + bi, f0 = gf[s0] + bfv, i1 = gi[s0 + 1] + bi, f1 = gf[s0 + 1] + bfv;
        const float lf0 = logsigf_(f0), lf1 = logsigf_(f1);
        const float p1 = lf0 + lf1; float incl = p1;
#pragma unroll
        for (int o = 1; o < 64; o <<= 1) { const float t = __shfl_up(incl, o); if (lane >= o) incl += t; }
        const float excl = incl - p1, b0 = excl + lf0, b1 = excl + p1;
        const float a0 = i0 - b0, a1 = i1 - b1;
        float am = fmaxf(a0, a1);
#pragma unroll
        for (int o = 1; o < 64; o <<= 1) am = fmaxf(am, __shfl_xor(am, o));
        const float bL = __int_as_float(__builtin_amdgcn_readlane(__float_as_int(b1), 63));
        wkv[s0] = __expf(a0 - am); wkv[s0 + 1] = __expf(a1 - am);
        if (lane == 0) { f32x2 sc; sc.x = am; sc.y = bL; ((GAS f32x2*)(ws + OFF_MSC))[item] = sc; }
    }
    __syncthreads();
#pragma unroll 2
    for (int i = 0; i < 4; ++i) {
        const int task = tid + 512 * i, row = task >> 4, cgp = task & 15;
        f32x4 y0, y1;
        conv_silu8(mraw, convw, convb, b, c * 128 + row, h * 128 + cgp * 8, y0, y1);
        *(GAS u32x4*)(mq + (size_t)(tok0 + row) * 512 + h * 128 + cgp * 8) = pk8(y0, y1);
        conv_silu8(mraw, convw, convb, b, c * 128 + row, 512 + h * 128 + cgp * 8, y0, y1);
        y0 *= 0.08838834764831845f; y1 *= 0.08838834764831845f;
        *(GAS u32x4*)(mk + (size_t)(tok0 + row) * 512 + h * 128 + cgp * 8) = pk8(y0, y1);
        const float wk = wkv[row];
        y0 *= wk; y1 *= wk;
        *(LAS u32x4*)(Kp + (row * KPST + cgp * 8) * 2) = pk8(y0, y1);
    }
#pragma unroll
    for (int i = 0; i < 8; ++i) {
        const int c2 = tid + 512 * i, row = c2 >> 5, ch = c2 & 31;
        *(LAS u32x4*)(Vs + (row * VST + ch * 8) * 2) = *(const GAS u32x4*)(mv + (size_t)(tok0 + row) * 1024 + h * 256 + ch * 8);
    }
    __syncthreads();
    f32x4 acc[16];
#pragma unroll
    for (int i = 0; i < 16; ++i) acc[i] = (f32x4){0.f, 0.f, 0.f, 0.f};
#pragma unroll
    for (int kk = 0; kk < 4; ++kk) {
        LAS unsigned char* px = Kp + ((kk * 32 + quad * 8 + (lq >> 2)) * KPST + 16 * wave + (lq & 3) * 4) * 2;
        const bf16x8 xf = mk8(lds_tr(px), lds_tr(px + 4 * KPST * 2));
#pragma unroll
        for (int vt = 0; vt < 16; ++vt) {
            LAS unsigned char* py = Vs + ((kk * 32 + quad * 8 + (lq >> 2)) * VST + vt * 16 + (lq & 3) * 4) * 2;
            acc[vt] = mfma16(xf, mk8(lds_tr(py), lds_tr(py + 4 * VST * 2)), acc[vt]);
        }
    }
    bf16_t* kl = (bf16_t*)(ws + OFF_KLOC) + (size_t)item * 256 * 128;
#pragma unroll
    for (int vt = 0; vt < 16; ++vt) { u32x2 w2; w2.x = pk2(acc[vt][0], acc[vt][1]); w2.y = pk2(acc[vt][2], acc[vt][3]); *(GAS u32x2*)(kl + (size_t)(vt * 16 + lq) * 128 + 16 * wave + quad * 4) = w2; }
    if (tid < 128) {
        float sum = 0.f;
#pragma unroll 8
        for (int s = 0; s < 128; ++s) sum += bf2f(*(const LAS unsigned short*)(Kp + (s * KPST + tid) * 2));
        ((GAS float*)(ws + OFF_NLOC))[(size_t)item * 128 + tid] = sum;
    }
}

__device__ __forceinline__ void mlstm_B(const Params& p, int li, LAS unsigned char* lds, int item) {
    int tid = threadIdx.x; asm volatile("" : "+v"(tid));
    const int wave = __builtin_amdgcn_readfirstlane(tid >> 6), lane = tid & 63, lq = lane & 15, quad = lane >> 4;
    const int half = item & 1, ci = item >> 1, bh = ci >> 4, c = ci & 15, b = bh >> 2, h = bh & 3;
    constexpr int QST = 136, VST = 144, CST = 136;
    LAS unsigned char* Qs = lds;
    LAS unsigned char* KWs = lds + 34816;
    LAS unsigned char* Vs = lds + 69632;
    LAS unsigned char* CTs = lds + 106496;
    LAS float* bcum = (LAS float*)(lds + 141312);
    LAS float* aval = bcum + 128; LAS float* Mt = aval + 128; LAS float* nvec = Mt + 128;
    unsigned char* ws = opaque_ws(p);
    const bf16_t* mv = (const bf16_t*)(ws + OFF_MV);
    const bf16_t* mo = (const bf16_t*)(ws + OFF_MO);
    const float* gates = (const float*)(ws + OFF_GATES);
    const bf16_t* mq = (const bf16_t*)(ws + OFF_MQ); const bf16_t* mk = (const bf16_t*)(ws + OFF_MK);
    bf16_t* mix = (bf16_t*)(ws + OFF_MIXE);
    const int tok0 = b * SEQ + c * 128;
    __syncthreads();
    float m_prev = 0.f;
    {
        f32x4 ca[8]; float na = 0.f;
#pragma unroll
        for (int i = 0; i < 8; ++i) ca[i] = (f32x4){0.f, 0.f, 0.f, 0.f};
        const GAS f32x2* msc = (const GAS f32x2*)(ws + OFF_MSC) + bh * 16;
        for (int c2 = 0; c2 < c; ++c2) {
            const f32x2 sc = msc[c2];
            const float Ml = fmaxf(m_prev, sc.x), dec = __expf(m_prev - Ml), wl = __expf(sc.x - Ml);
            const GAS u32x2* kl = (const GAS u32x2*)((const bf16_t*)(ws + OFF_KLOC) + (size_t)(bh * 16 + c2) * 256 * 128 + (size_t)half * 128 * 128) + tid;
#pragma unroll
            for (int i = 0; i < 8; ++i) { const u32x2 w2 = kl[512 * i]; ca[i] = ca[i] * dec + (f32x4){bflo(w2.x), bfhi(w2.x), bflo(w2.y), bfhi(w2.y)} * wl; }
            if (tid < 128) na = na * dec + wl * ((const GAS float*)(ws + OFF_NLOC))[(size_t)(bh * 16 + c2) * 128 + tid];
            m_prev = sc.y + Ml;
        }
#pragma unroll
        for (int i = 0; i < 8; ++i) {
            const int e4 = tid + 512 * i, v = e4 >> 5, d0 = (e4 & 31) * 4;
            u32x2 w2; w2.x = pk2(ca[i][0], ca[i][1]); w2.y = pk2(ca[i][2], ca[i][3]);
            *(LAS u32x2*)(CTs + (v * CST + d0) * 2) = w2;
        }
        if (tid < 128) nvec[tid] = na;
    }
    if (wave == 0) {
        const float bi = p.b_i[li * 4 + h], bfv = p.b_f[li * 4 + h];
        const int s0 = 2 * lane;
        const GAS float* g0 = (const GAS float*)(gates + (size_t)(tok0 + s0) * 8);
        const float i0 = g0[h] + bi, f0 = g0[4 + h] + bfv, i1 = g0[8 + h] + bi, f1 = g0[12 + h] + bfv;
        const float lf0 = logsigf_(f0), lf1 = logsigf_(f1);
        const float p1 = lf0 + lf1; float incl = p1;
#pragma unroll
        for (int o = 1; o < 64; o <<= 1) { const float t = __shfl_up(incl, o); if (lane >= o) incl += t; }
        const float excl = incl - p1, b0 = excl + lf0, b1 = excl + p1;
        const float a0 = i0 - b0, a1 = i1 - b1;
        float cm = fmaxf(a0, a1);
#pragma unroll
        for (int o = 1; o < 64; o <<= 1) { const float t = __shfl_up(cm, o); if (lane >= o) cm = fmaxf(cm, t); }
        float cmprev = __shfl_up(cm, 1); if (lane == 0) cmprev = -1e30f;
        const float M0 = fmaxf(m_prev, fmaxf(cmprev, a0)), M1 = fmaxf(m_prev, cm);
        bcum[s0] = b0; bcum[s0 + 1] = b1; aval[s0] = a0; aval[s0 + 1] = a1; Mt[s0] = M0; Mt[s0 + 1] = M1;
    }
#pragma unroll
    for (int i = 0; i < 4; ++i) {
        const int c2 = tid + 512 * i, row = c2 >> 4, ch = c2 & 15;
        *(LAS u32x4*)(Qs + (row * QST + ch * 8) * 2) = *(const GAS u32x4*)(mq + (size_t)(tok0 + row) * 512 + h * 128 + ch * 8);
        *(LAS u32x4*)(KWs + (row * QST + ch * 8) * 2) = *(const GAS u32x4*)(mk + (size_t)(tok0 + row) * 512 + h * 128 + ch * 8);
        *(LAS u32x4*)(Vs + (row * VST + ch * 8) * 2) = *(const GAS u32x4*)(mv + (size_t)(tok0 + row) * 1024 + h * 256 + half * 128 + ch * 8);
    }
    __syncthreads();
    const int trow = 16 * wave + lq;
    bf16x8 qf[4];
#pragma unroll
    for (int kk = 0; kk < 4; ++kk) qf[kk] = *(const LAS bf16x8*)(Qs + (trow * QST + kk * 32 + quad * 8) * 2);
    const float Mt_l = Mt[trow];
    unsigned wpk[8][2]; float dW = 0.f;
#pragma unroll
    for (int st = 0; st < 8; ++st) {
        if (st <= wave) {
            f32x4 s = (f32x4){0.f, 0.f, 0.f, 0.f};
#pragma unroll
            for (int kk = 0; kk < 4; ++kk) { const bf16x8 kf = *(const LAS bf16x8*)(KWs + ((16 * st + lq) * QST + kk * 32 + quad * 8) * 2); s = mfma16(kf, qf[kk], s); }
            const f32x4 av = *(const LAS f32x4*)(aval + 16 * st + quad * 4);
            float w[4];
#pragma unroll
            for (int jj = 0; jj < 4; ++jj) {
                const int sidx = 16 * st + quad * 4 + jj;
                const float e = (sidx <= trow) ? __expf(fminf(av[jj] - Mt_l, 0.f)) * s[jj] : 0.f;
                w[jj] = e; dW += e;
            }
            wpk[st][0] = pk2(w[0], w[1]); wpk[st][1] = pk2(w[2], w[3]);
        } else { wpk[st][0] = 0u; wpk[st][1] = 0u; }
    }
    dW += __shfl_xor(dW, 16); dW += __shfl_xor(dW, 32);
    __syncthreads();
#pragma unroll
    for (int st = 0; st < 8; ++st) { u32x2 w2; w2.x = wpk[st][0]; w2.y = wpk[st][1]; *(LAS u32x2*)(KWs + (trow * QST + 16 * st + quad * 4) * 2) = w2; }
    __syncthreads();
    f32x4 nW[8], nC[8];
#pragma unroll
    for (int i = 0; i < 8; ++i) { nW[i] = (f32x4){0.f, 0.f, 0.f, 0.f}; nC[i] = (f32x4){0.f, 0.f, 0.f, 0.f}; }
    const int kkmax = wave >> 1;
#pragma unroll
    for (int kk = 0; kk < 4; ++kk) {
        if (kk <= kkmax) {
            const bf16x8 wf = *(const LAS bf16x8*)(KWs + (trow * QST + kk * 32 + quad * 8) * 2);
#pragma unroll
            for (int vt = 0; vt < 8; ++vt) {
                LAS unsigned char* pa = Vs + ((kk * 32 + quad * 8 + (lq >> 2)) * VST + vt * 16 + (lq & 3) * 4) * 2;
                nW[vt] = mfma16(mk8(lds_tr(pa), lds_tr(pa + 4 * VST * 2)), wf, nW[vt]);
            }
        }
    }
#pragma unroll
    for (int kk = 0; kk < 4; ++kk)
#pragma unroll
        for (int vt = 0; vt < 8; ++vt) {
            const bf16x8 cf = *(const LAS bf16x8*)(CTs + ((vt * 16 + lq) * CST + kk * 32 + quad * 8) * 2);
            nC[vt] = mfma16(cf, qf[kk], nC[vt]);
        }
    float qn = 0.f;
#pragma unroll
    for (int e8 = 0; e8 < 4; ++e8) {
        const u32x4 qq = *(const LAS u32x4*)(Qs + (trow * QST + quad * 32 + e8 * 8) * 2);
        const f32x4 n0 = *(const LAS f32x4*)(nvec + quad * 32 + e8 * 8), n1 = *(const LAS f32x4*)(nvec + quad * 32 + e8 * 8 + 4);
        qn += bflo(qq.x) * n0[0] + bfhi(qq.x) * n0[1] + bflo(qq.y) * n0[2] + bfhi(qq.y) * n0[3] + bflo(qq.z) * n1[0] + bfhi(qq.z) * n1[1] + bflo(qq.w) * n1[2] + bfhi(qq.w) * n1[3];
    }
    qn += __shfl_xor(qn, 16); qn += __shfl_xor(qn, 32);
    {
        const float inter = __expf(m_prev - Mt_l);
        const float den = dW + inter * qn;
        const float mrow = bcum[trow] + Mt_l;
        const float inv = 1.0f / fmaxf(fabsf(den), __expf(-mrow));
        const size_t tok = (size_t)(tok0 + trow);
#pragma unroll
        for (int vt = 0; vt < 8; ++vt) {
            const int vcol = h * 256 + half * 128 + vt * 16 + quad * 4;
            const u32x2 og = *(const GAS u32x2*)(mo + tok * 1024 + vcol);
            const float h0 = (nW[vt][0] + inter * nC[vt][0]) * inv * bflo(og.x), h1 = (nW[vt][1] + inter * nC[vt][1]) * inv * bfhi(og.x);
            const float h2 = (nW[vt][2] + inter * nC[vt][2]) * inv * bflo(og.y), h3 = (nW[vt][3] + inter * nC[vt][3]) * inv * bfhi(og.y);
            u32x2 w2; w2.x = pk2(h0, h1); w2.y = pk2(h2, h3);
            *(GAS u32x2*)(mix + xb_off((int)tok, 1024 + vcol)) = w2;
        }
    }
}


#define XB_TMO      128
#define XB_XCNT(j)  (256  + 64 * (j))
#define XB_XSUB(j)  (1280 + 64 * (j))
#define XB_XGEN(j)  (2304 + 64 * (j))
#define XB_TOP      3328
#define XB_TOPGEN   3392
#define XB_SPIN_CAP (1u << 20)
__device__ __forceinline__ unsigned xb_ld(unsigned* p)              { return __hip_atomic_load((GAS unsigned*)p, __ATOMIC_RELAXED, __HIP_MEMORY_SCOPE_AGENT); }
__device__ __forceinline__ unsigned xb_add(unsigned* p, unsigned v) { return __hip_atomic_fetch_add((GAS unsigned*)p, v, __ATOMIC_RELAXED, __HIP_MEMORY_SCOPE_AGENT); }
__device__ __forceinline__ unsigned xb_xcc_id() { return (unsigned)__builtin_amdgcn_s_getreg((3 << 11) | 20) & 0xFu; }
#define XB_SPIN(cond, bar) do { unsigned _sp = 0; while (cond) { __builtin_amdgcn_s_sleep(1); \
    if ((++_sp & 255u) == 0u) { if (xb_ld(&(bar)[XB_TMO])) break; if (_sp > XB_SPIN_CAP) { atomicAdd(&(bar)[XB_TMO], 1u); break; } } } } while (0)
struct XcdBarrier { unsigned* bar; unsigned x; volatile LAS unsigned* st; };
__device__ __forceinline__ XcdBarrier xcd_barrier_post(unsigned* bar, volatile LAS unsigned* st) {
    XcdBarrier b; b.bar = bar; b.x = xb_xcc_id(); b.st = st;
    if (threadIdx.x == 0) (void)xb_add(&bar[XB_XCNT(b.x)], 1u);
    return b;
}
__device__ __forceinline__ void xcd_barrier_complete(unsigned* bar, unsigned x, unsigned& nloc, unsigned& nx) {
    const unsigned G = gridDim.x * gridDim.y * gridDim.z;
    unsigned sum, cnt, mine, sp = 0u;
    for (;;) {
        sum = 0u; cnt = 0u; mine = 0u;
#pragma unroll
        for (unsigned j = 0; j < 16; ++j) { const unsigned c = xb_ld(&bar[XB_XCNT(j)]); sum += c; cnt += (c > 0u) ? 1u : 0u; mine = (j == x) ? c : mine; }
        if (sum == G) break;
        __builtin_amdgcn_s_sleep(1);
        if ((++sp & 255u) == 0u) { if (xb_ld(&bar[XB_TMO])) break; if (sp > XB_SPIN_CAP) { atomicAdd(&bar[XB_TMO], 1u); break; } }
    }
    nloc = mine > 0u ? mine : 1u; nx = cnt > 0u ? cnt : 1u;
}
__device__ __forceinline__ void xcd_barrier(const XcdBarrier& b) {
    asm volatile("s_waitcnt vmcnt(0)" ::: "memory");
    __syncthreads();
    if (threadIdx.x == 0) {
        unsigned* bar = b.bar;
        __builtin_amdgcn_s_waitcnt(0);
        unsigned nloc = b.st[0], nx = b.st[1];
        if (nloc == 0u) { xcd_barrier_complete(bar, b.x, nloc, nx); b.st[0] = nloc; b.st[1] = nx; }
        const unsigned old = xb_add(&bar[XB_XSUB(b.x)], 1u);
        const unsigned gen = old / nloc;
        if (old + 1u == (gen + 1u) * nloc) {
            __builtin_amdgcn_fence(__ATOMIC_RELEASE, "agent");
            asm volatile("s_waitcnt vmcnt(0)" ::: "memory");
            const unsigned og = xb_add(&bar[XB_TOP], 1u);
            const unsigned tg = og / nx;
            if (og + 1u == (tg + 1u) * nx) xb_add(&bar[XB_TOPGEN], 1u);
            else XB_SPIN(xb_ld(&bar[XB_TOPGEN]) == tg, bar);
            __builtin_amdgcn_fence(__ATOMIC_ACQUIRE, "agent");
            xb_add(&bar[XB_XGEN(b.x)], 1u);
            asm volatile("s_waitcnt vmcnt(0)" ::: "memory");
        } else {
            XB_SPIN(xb_ld(&bar[XB_XGEN(b.x)]) == gen, bar);
            __builtin_amdgcn_fence(__ATOMIC_ACQUIRE, "agent");
            asm volatile("s_waitcnt vmcnt(0)" ::: "memory");
        }
    }
    __syncthreads();
}

__device__ __forceinline__ void phase_even_mix(const Params& p, int li, LAS unsigned char* lds, unsigned* ctr) {
    unsigned char* ws = opaque_ws(p);
    const bool x8 = (gridDim.x == 256);
    const int xcd = x8 ? (int)(blockIdx.x & 7) : 0, nq = x8 ? 96 : 768;
    unsigned* myctr = ctr + xcd * 32;
    for (;;) {
        __syncthreads();
        if (threadIdx.x == 0) *(LAS int*)(lds + QWORD_OFF) = (int)__hip_atomic_fetch_add((GAS unsigned*)myctr, 1u, __ATOMIC_RELAXED, __HIP_MEMORY_SCOPE_AGENT);
        __syncthreads();
        const int q = *(LAS int*)(lds + QWORD_OFF);
        if (q >= nq) break;
        int mla_it = -1, b_it = -1;
        if (x8) { if (q < 32) mla_it = q; else b_it = q - 32; } else { if (q < 256) mla_it = q; else b_it = 767 - q; }
        if (b_it >= 0) {
            const int item = x8 ? ((((2 * xcd + (b_it & 1)) * 16 + (15 - (b_it >> 2))) << 1) | ((b_it >> 1) & 1)) : b_it;
            mlstm_B(p, li, lds, item);
        } else {
            int qb, bh;
            if (x8) { qb = 7 - (mla_it >> 2); bh = xcd * 4 + (mla_it & 3); } else { qb = 7 - (mla_it >> 5); bh = mla_it & 31; }
            const int b = bh >> 3, h = bh & 7;
            AttnArgs a; a.q = (const bf16_t*)(ws + OFF_QB); a.k0 = (const bf16_t*)(ws + OFF_KNOPE); a.k1 = (const bf16_t*)(ws + OFF_KROPE); a.v = (const bf16_t*)(ws + OFF_VB);
            a.h = h; a.tokbase = b * SEQ; a.dil = 1; a.qb = qb; a.kt_begin = 0; a.kt_end = 4 * qb + 4;
            a.out = (bf16_t*)(ws + OFF_MIXE); a.ostride = 2048; a.ooff = h * 128; a.lse = nullptr; a.oblk = 1;
            attn_item<0>(a, lds);
        }
    }
}

__device__ __forceinline__ void phase_dilated(const Params& p, LAS unsigned char* lds) {
    unsigned char* ws = opaque_ws(p);
    const bool x8 = (gridDim.x == 256);
    const int nit = x8 ? 192 : 1536, step = x8 ? 32 : (int)gridDim.x, first = x8 ? (int)(blockIdx.x >> 3) : (int)blockIdx.x, base = x8 ? (int)(blockIdx.x & 7) * 192 : 0;
    for (int j = first; j < nit; j += step) {
        const int it = base + j;
        const int bh = it / 24, r = it % 24, g = r >> 3, rr = r & 7, b = bh >> 4, h = bh & 15;
        AttnArgs a; const bf16_t* qkv = (const bf16_t*)(ws + OFF_QKV);
        a.q = qkv; a.k0 = qkv + HM_TENSOR; a.k1 = nullptr; a.v = qkv + 2 * HM_TENSOR; a.h = h;
        a.out = (bf16_t*)(ws + OFF_OG) + (size_t)g * T * 2048; a.ostride = 2048; a.ooff = h * 128; a.lse = (float*)(ws + OFF_LSE) + (size_t)g * T * 16; a.oblk = 0;
        if (g == 2) {
            a.tokbase = b * SEQ + 2 * rr; a.dil = 16; a.qb = 0; a.kt_begin = 0; a.kt_end = 2;
            attn_item<2>(a, lds);
        } else {
            int n;
            if (g == 0) { a.dil = 1; a.tokbase = b * SEQ; n = rr; } else { a.dil = 4; a.tokbase = b * SEQ + (rr >> 1); n = rr & 1; }
            a.qb = n; a.kt_begin = (n > 0) ? 4 * n - 2 : 0; a.kt_end = 4 * n + 4;
            attn_item<1>(a, lds);
        }
    }
}

__device__ __forceinline__ void phase_merge(const Params& p) {
    unsigned char* ws = opaque_ws(p);
    const bf16_t* og = (const bf16_t*)(ws + OFF_OG); const GAS float* lse = (const GAS float*)(ws + OFF_LSE); bf16_t* mix = (bf16_t*)(ws + OFF_MIXO);
    int tid_ = threadIdx.x; asm volatile("" : "+v"(tid_));
    const size_t n = (size_t)T * 256, gt = (size_t)blockIdx.x * 512 + tid_, ngt = (size_t)gridDim.x * 512;
    for (size_t i = gt; i < n; i += ngt) {
        const size_t tok = i >> 8; const int c8 = (int)(i & 255), h = c8 >> 4;
        const float l0 = lse[tok * 16 + h], l1 = lse[(size_t)T * 16 + tok * 16 + h], l2 = lse[(size_t)2 * T * 16 + tok * 16 + h];
        const float mx = fmaxf(l0, fmaxf(l1, l2));
        float w0 = __builtin_amdgcn_exp2f(l0 - mx), w1 = __builtin_amdgcn_exp2f(l1 - mx), w2 = __builtin_amdgcn_exp2f(l2 - mx);
        const float inv = 1.0f / (w0 + w1 + w2); w0 *= inv; w1 *= inv; w2 *= inv;
        const u32x4 a = *(const GAS u32x4*)(og + tok * 2048 + c8 * 8), b = *(const GAS u32x4*)(og + (size_t)T * 2048 + tok * 2048 + c8 * 8), c = *(const GAS u32x4*)(og + (size_t)2 * T * 2048 + tok * 2048 + c8 * 8);
        u32x4 o;
        o.x = pk2(w0 * bflo(a.x) + w1 * bflo(b.x) + w2 * bflo(c.x), w0 * bfhi(a.x) + w1 * bfhi(b.x) + w2 * bfhi(c.x));
        o.y = pk2(w0 * bflo(a.y) + w1 * bflo(b.y) + w2 * bflo(c.y), w0 * bfhi(a.y) + w1 * bfhi(b.y) + w2 * bfhi(c.y));
        o.z = pk2(w0 * bflo(a.z) + w1 * bflo(b.z) + w2 * bflo(c.z), w0 * bfhi(a.z) + w1 * bfhi(b.z) + w2 * bfhi(c.z));
        o.w = pk2(w0 * bflo(a.w) + w1 * bflo(b.w) + w2 * bflo(c.w), w0 * bfhi(a.w) + w1 * bfhi(b.w) + w2 * bfhi(c.w));
        *(GAS u32x4*)(mix + xb_off((int)tok, c8 * 8)) = o;
    }
}

__device__ __forceinline__ void phase_final(const Params& p) {
    unsigned char* ws = opaque_ws(p);
    int tid_ = threadIdx.x; asm volatile("" : "+v"(tid_));
    const int wave = tid_ >> 6, lane = tid_ & 63, gw = blockIdx.x * 8 + wave, ngw = gridDim.x * 8;
    for (int row = gw; row < T; row += ngw) {
        const float rs = row_rstd((const float*)(ws + OFF_SSX) + (size_t)row * 32, 32, 1.0f / 2048.0f);
        const bf16_t* xbase = (const bf16_t*)(ws + OFF_XB);
        const GAS f32x4* gr = (const GAS f32x4*)p.norm_final + lane;
        GAS f32x4* orow = (GAS f32x4*)(p.out + (size_t)row * DM) + lane;
#pragma unroll
        for (int j = 0; j < 8; ++j) { const u32x2 w = *(const GAS u32x2*)(xbase + xb_off(row, 4 * (lane + 64 * j))); const f32x4 v = (f32x4){bflo(w.x), bfhi(w.x), bflo(w.y), bfhi(w.y)}; orow[64 * j] = v * rs * gr[64 * j]; }
    }
}

__device__ __forceinline__ void phase_mlp(const Params& p, int layer, LAS unsigned char* lds, const XcdBarrier& xb) {
    unsigned char* ws = opaque_ws(p);
    { EpiRelu2 E; E.ssx = (const float*)(ws + OFF_SSX); E.ub = (bf16_t*)(ws + OFF_U);
      run_gemm<32>(lds, (const bf16_t*)(ws + OFF_XB), (const bf16_t*)(ws + OFF_W1 + (size_t)layer * SZ_W1), FF, DM, E, E.ssx, true); }
    xcd_barrier(xb);
    asm volatile("" : "+s"(ws));
    { EpiRes E; E.xb = (bf16_t*)(ws + OFF_XB); E.ssx = (float*)(ws + OFF_SSX);
      run_gemm<0>(lds, (const bf16_t*)(ws + OFF_U), (const bf16_t*)(ws + OFF_W2 + (size_t)layer * SZ_W1), DM, FF, E, nullptr, true); }
    xcd_barrier(xb);
}

__global__ void __launch_bounds__(512, 2) trunk_fwd(Params p) {
    extern __shared__ __attribute__((aligned(16))) unsigned char shm[];
    LAS unsigned char* lds = (LAS unsigned char*)shm;
    cg::grid_group grid = cg::this_grid();
    unsigned char* ws = opaque_ws(p);
    if (threadIdx.x == 0) { *(LAS u32x4*)(lds + QWORD_OFF - 16) = (u32x4){0u, 0u, 0u, 0u}; }
    __syncthreads();
    const XcdBarrier xb = xcd_barrier_post((unsigned*)(ws + OFF_BAR), (volatile LAS unsigned*)(lds + QWORD_OFF - 16));
    phase_prep(p, lds);
    xcd_barrier(xb);
    if (p.out == nullptr) grid.sync();
#if defined(PROBE_PREP)
    phase_prep(p, lds);
    xcd_barrier(xb);
#endif
#pragma unroll 1
    for (int li = 0; li < 2; ++li) {
        asm volatile("" : "+s"(ws));
        asm volatile("" : "+s"(ws));
        { EpiIn E; E.ssx = (const float*)(ws + OFF_SSX); E.cq = (bf16_t*)(ws + OFF_CQ); E.ckv = (bf16_t*)(ws + OFF_CKV); E.mraw = (float*)(ws + OFF_MRAW); E.mv = (bf16_t*)(ws + OFF_MV);
          E.mo = (bf16_t*)(ws + OFF_MO); E.krope = (bf16_t*)(ws + OFF_KROPE); E.gates = (float*)(ws + OFF_GATES); E.sscq = (float*)(ws + OFF_SSCQ); E.ssckv = (float*)(ws + OFF_SSCKV);
          E.ropeA = (const f32x2*)(ws + OFF_ROPEA);
          run_gemm<32>(lds, (const bf16_t*)(ws + OFF_XB), (const bf16_t*)(ws + OFF_WIN + (size_t)li * SZ_WIN), 4096, DM, E, E.ssx, true, NIN); }
        { EpiPart E2; E2.part = (float*)(ws + OFF_PART);
          run_gemm_splitk(lds, (const bf16_t*)(ws + OFF_XB), (const bf16_t*)(ws + OFF_WIN + (size_t)li * SZ_WIN) + (size_t)4096 * 64, E2); }
        xcd_barrier(xb);
        for (int it = blockIdx.x; it < 256; it += gridDim.x) mlstm_A(p, li, lds, it);
        __syncthreads();
        asm volatile("" : "+s"(ws));
        { EpiUQ E; E.sscq = (const float*)(ws + OFF_SSCQ); E.qb = (bf16_t*)(ws + OFF_QB); E.ropeA = (const f32x2*)(ws + OFF_ROPEA);
          run_gemm<8>(lds, (const bf16_t*)(ws + OFF_CQ), (const bf16_t*)(ws + OFF_WUQ + (size_t)li * SZ_WUQ), 1536, 512, E, E.sscq, true); }
        asm volatile("" : "+s"(ws));
        { EpiUKV E; E.ssckv = (const float*)(ws + OFF_SSCKV); E.knope = (bf16_t*)(ws + OFF_KNOPE); E.vb = (bf16_t*)(ws + OFF_VB);
          run_gemm<8>(lds, (const bf16_t*)(ws + OFF_CKV), (const bf16_t*)(ws + OFF_WUKV + (size_t)li * SZ_WUKV), 2048, 512, E, E.ssckv, true); }
        xcd_barrier(xb);
        phase_even_mix(p, li, lds, (unsigned*)(ws + OFF_CTL) + 512 * li);
        xcd_barrier(xb);
#if defined(PROBE_MIX)
        phase_even_mix(p, li, lds, (unsigned*)(ws + OFF_CTL) + 64 * li + 32);
        xcd_barrier(xb);
#endif
        asm volatile("" : "+s"(ws));
        { EpiRes E; E.xb = (bf16_t*)(ws + OFF_XB); E.ssx = (float*)(ws + OFF_SSX);
          run_gemm<0>(lds, (const bf16_t*)(ws + OFF_MIXE), (const bf16_t*)(ws + OFF_WEVO + (size_t)li * SZ_WO), DM, DM, E, nullptr, true); }
        xcd_barrier(xb);
        phase_mlp(p, 2 * li, lds, xb);
        asm volatile("" : "+s"(ws));
        { EpiQKV E; E.ssx = (const float*)(ws + OFF_SSX); E.qkv = (bf16_t*)(ws + OFF_QKV); E.ropeB = (const f32x2*)(ws + OFF_ROPEB);
          run_gemm<32>(lds, (const bf16_t*)(ws + OFF_XB), (const bf16_t*)(ws + OFF_WQKV + (size_t)li * SZ_WQKV), 6144, DM, E, E.ssx, true); }
        xcd_barrier(xb);
        phase_dilated(p, lds);
        xcd_barrier(xb);
        phase_merge(p);
        xcd_barrier(xb);
#if defined(PROBE_DIL)
        phase_dilated(p, lds);
        xcd_barrier(xb);
        phase_merge(p);
        xcd_barrier(xb);
#endif
        asm volatile("" : "+s"(ws));
        { EpiRes E; E.xb = (bf16_t*)(ws + OFF_XB); E.ssx = (float*)(ws + OFF_SSX);
          run_gemm<0>(lds, (const bf16_t*)(ws + OFF_MIXO), (const bf16_t*)(ws + OFF_WODO + (size_t)li * SZ_WO), DM, DM, E, nullptr, true); }
        xcd_barrier(xb);
        phase_mlp(p, 2 * li + 1, lds, xb);
    }
    phase_final(p);
}

extern "C" void kernel_launch(void* const* d_in, const int* in_sizes, int n_in, void* d_out, int out_size, void* d_ws, size_t ws_size, hipStream_t stream) {
    static int grid = 0;
    if (grid == 0) {
        if (n_in != 18 || ws_size < WS_END) { fprintf(stderr, "kernel_launch: need 18 inputs and %zu bytes of workspace (got %d, %zu)\n", (size_t)WS_END, n_in, ws_size); grid = -1; return; }
        int dev = 0, cus = 0, per_cu = 0;
        hipGetDevice(&dev);
        hipDeviceGetAttribute(&cus, hipDeviceAttributeMultiprocessorCount, dev);
        if (hipFuncSetAttribute((const void*)trunk_fwd, hipFuncAttributeMaxDynamicSharedMemorySize, LDS_BYTES) != hipSuccess) { fprintf(stderr, "kernel_launch: hipFuncSetAttribute failed\n"); grid = -1; return; }
        if (hipOccupancyMaxActiveBlocksPerMultiprocessor(&per_cu, (const void*)trunk_fwd, 512, LDS_BYTES) != hipSuccess || per_cu < 1) { fprintf(stderr, "kernel_launch: occupancy query gave %d\n", per_cu); per_cu = 1; }
        (void)hipGetLastError();
        grid = cus * 1;
    }
    if (grid < 0) return;
    (void)hipMemsetAsync((char*)d_ws + OFF_CTL, 0, CTL_BYTES, stream);
    Params p{};
    p.x = (const float*)d_in[0]; p.norm_mix = (const float*)d_in[1]; p.norm_mlp = (const float*)d_in[2]; p.ev_w_in = (const float*)d_in[3];
    p.mla_q_norm = (const float*)d_in[4]; p.mla_w_uq = (const float*)d_in[5]; p.mla_kv_norm = (const float*)d_in[6]; p.mla_w_ukv = (const float*)d_in[7];
    p.conv_w = (const float*)d_in[8]; p.conv_b = (const float*)d_in[9]; p.b_i = (const float*)d_in[10]; p.b_f = (const float*)d_in[11];
    p.ev_w_out = (const float*)d_in[12]; p.od_w_qkv = (const float*)d_in[13]; p.od_w_out = (const float*)d_in[14]; p.mlp_w1 = (const float*)d_in[15];
    p.mlp_w2 = (const float*)d_in[16]; p.norm_final = (const float*)d_in[17];
    p.out = (float*)d_out; p.ws = (unsigned char*)d_ws;
    void* args[] = {&p};
    hipError_t e = hipLaunchCooperativeKernel((const void*)trunk_fwd, dim3(grid), dim3(512), args, LDS_BYTES, stream);
    if (e != hipSuccess) fprintf(stderr, "cooperative launch failed: %s (grid %d)\n", hipGetErrorString(e), grid);
}
```

```cpp
#include <hip/hip_runtime.h>
#include <hip/hip_cooperative_groups.h>
#include <cstdio>
#include <cstdint>
namespace cg = cooperative_groups;

#define LAS __attribute__((address_space(3)))
#define GAS __attribute__((address_space(1)))
typedef unsigned short bf16_t;
typedef short bf16x8 __attribute__((ext_vector_type(8)));
typedef short s16x4 __attribute__((ext_vector_type(4)));
typedef float f32x4 __attribute__((ext_vector_type(4)));
typedef float f32x2 __attribute__((ext_vector_type(2)));
typedef unsigned u32x4 __attribute__((ext_vector_type(4)));
typedef unsigned u32x2 __attribute__((ext_vector_type(2)));

constexpr int T = 8192, SEQ = 2048, DM = 2048, FF = 8192;
constexpr int NIN = 4352;
constexpr float EPS = 1e-6f;
constexpr float LOG2E = 1.4426950408889634f;
constexpr int LDS_BYTES = 152 * 1024;
constexpr int QWORD_OFF = LDS_BYTES - 16;

constexpr size_t OFF_CTL = 0;
constexpr size_t OFF_BAR = 4096;
constexpr size_t CTL_BYTES = 4096 + 16384;
constexpr size_t OFF_ROPEA = CTL_BYTES;
constexpr size_t OFF_ROPEB = OFF_ROPEA + (size_t)2048 * 32 * 8;
constexpr size_t OFF_SSX = OFF_ROPEB + (size_t)2048 * 64 * 8;
constexpr size_t OFF_SSCQ = OFF_SSX + (size_t)T * 32 * 4;
constexpr size_t OFF_SSCKV = OFF_SSCQ + (size_t)T * 8 * 4;
constexpr size_t OFF_X = OFF_SSCKV + (size_t)T * 8 * 4;
constexpr size_t OFF_XB = OFF_X + (size_t)T * DM * 4;
constexpr size_t OFF_W = OFF_XB + (size_t)T * DM * 2;
constexpr size_t SZ_WIN = (size_t)NIN * 2048 * 2, SZ_WUQ = (size_t)1536 * 512 * 2, SZ_WUKV = (size_t)2048 * 512 * 2,
                 SZ_WO = (size_t)2048 * 2048 * 2, SZ_WQKV = (size_t)6144 * 2048 * 2, SZ_W1 = (size_t)8192 * 2048 * 2;
constexpr size_t OFF_WIN = OFF_W;
constexpr size_t OFF_WUQ = OFF_WIN + 2 * SZ_WIN;
constexpr size_t OFF_WUKV = OFF_WUQ + 2 * SZ_WUQ;
constexpr size_t OFF_WEVO = OFF_WUKV + 2 * SZ_WUKV;
constexpr size_t OFF_WQKV = OFF_WEVO + 2 * SZ_WO;
constexpr size_t OFF_WODO = OFF_WQKV + 2 * SZ_WQKV;
constexpr size_t OFF_W1 = OFF_WODO + 2 * SZ_WO;
constexpr size_t OFF_W2 = OFF_W1 + 4 * SZ_W1;
constexpr size_t OFF_UN = OFF_W2 + 4 * SZ_W1;
constexpr size_t OFF_CQ = OFF_UN;
constexpr size_t OFF_CKV = OFF_CQ + (size_t)T * 512 * 2;
constexpr size_t OFF_MRAW = OFF_CKV + (size_t)T * 512 * 2;
constexpr size_t OFF_MV = OFF_MRAW + (size_t)T * 1024 * 4;
constexpr size_t OFF_MO = OFF_MV + (size_t)T * 1024 * 2;
constexpr size_t OFF_KROPE = OFF_MO + (size_t)T * 1024 * 2;
constexpr size_t OFF_GATES = OFF_KROPE + (size_t)T * 64 * 2;
constexpr size_t OFF_QB = OFF_GATES + (size_t)T * 8 * 4;
constexpr size_t OFF_KNOPE = OFF_QB + (size_t)T * 1536 * 2;
constexpr size_t OFF_VB = OFF_KNOPE + (size_t)T * 1024 * 2;
constexpr size_t OFF_MIXE = OFF_VB + (size_t)T * 1024 * 2;
constexpr size_t OFF_MQ = OFF_MIXE + (size_t)T * 2048 * 2;
constexpr size_t OFF_MK = OFF_MQ + (size_t)T * 512 * 2;
constexpr size_t OFF_KLOC = OFF_MK + (size_t)T * 512 * 2;
constexpr size_t OFF_NLOC = OFF_KLOC + (size_t)256 * 256 * 128 * 4;
constexpr size_t OFF_MSC = OFF_NLOC + (size_t)256 * 128 * 4;
constexpr size_t OFF_PART = OFF_MSC + 4096;
constexpr size_t END_EVEN = OFF_PART + (size_t)8 * T * 72 * 4;
constexpr size_t OFF_QKV = OFF_UN;
constexpr size_t OFF_OG = OFF_QKV + (size_t)T * 6144 * 2;
constexpr size_t OFF_LSE = OFF_OG + (size_t)3 * T * 2048 * 2;
constexpr size_t OFF_MIXO = OFF_LSE + (size_t)3 * T * 16 * 4;
constexpr size_t END_ODD = OFF_MIXO + (size_t)T * 2048 * 2;
constexpr size_t OFF_U = OFF_UN;
constexpr size_t END_U = OFF_U + (size_t)T * FF * 2;
constexpr size_t WS_END = (END_ODD > END_EVEN ? (END_ODD > END_U ? END_ODD : END_U) : (END_EVEN > END_U ? END_EVEN : END_U));

struct Params {
    const float *x, *norm_mix, *norm_mlp, *ev_w_in, *mla_q_norm, *mla_w_uq, *mla_kv_norm, *mla_w_ukv, *conv_w, *conv_b, *b_i, *b_f,
        *ev_w_out, *od_w_qkv, *od_w_out, *mlp_w1, *mlp_w2, *norm_final;
    float* out;
    unsigned char* ws;
};

__device__ __forceinline__ unsigned char* opaque_ws(const Params& p) { unsigned char* w = p.ws; asm volatile("" : "+s"(w)); return w; }

__device__ __forceinline__ unsigned f2bf(float f) { unsigned u = __float_as_uint(f); u += 0x7FFFu + ((u >> 16) & 1u); return u >> 16; }
typedef __bf16 bf16v2_ __attribute__((ext_vector_type(2)));
__device__ __forceinline__ unsigned pk2(float lo, float hi) { f32x2 v = {lo, hi}; bf16v2_ r = __builtin_convertvector(v, bf16v2_); return __builtin_bit_cast(unsigned, r); }
__device__ __forceinline__ float bf2f(unsigned short b) { return __uint_as_float(((unsigned)b) << 16); }
__device__ __forceinline__ float bflo(unsigned w) { return __uint_as_float(w << 16); }
__device__ __forceinline__ float bfhi(unsigned w) { return __uint_as_float(w & 0xFFFF0000u); }
__device__ __forceinline__ u32x4 pk8(f32x4 a, f32x4 b) { u32x4 o; o.x = pk2(a[0], a[1]); o.y = pk2(a[2], a[3]); o.z = pk2(b[0], b[1]); o.w = pk2(b[2], b[3]); return o; }
__device__ __forceinline__ float wave_sum(float v) {
#pragma unroll
    for (int o = 1; o < 64; o <<= 1) v += __shfl_xor(v, o);
    return v;
}
__device__ __forceinline__ float sigmoidf_(float x) { return 1.0f / (1.0f + __expf(-x)); }
__device__ __forceinline__ float row_rstd(const float* ss, int nslots, float invn) {
    float s = 0.f;
    for (int i = 0; i < nslots; i += 4) { f32x4 v = *(const GAS f32x4*)(ss + i); s += (v[0] + v[1]) + (v[2] + v[3]); }
    return rsqrtf(s * invn + EPS);
}
__device__ __forceinline__ bf16x8 mk8(s16x4 a, s16x4 b) { bf16x8 r; r[0] = a[0]; r[1] = a[1]; r[2] = a[2]; r[3] = a[3]; r[4] = b[0]; r[5] = b[1]; r[6] = b[2]; r[7] = b[3]; return r; }
__device__ __forceinline__ s16x4 lds_tr(LAS unsigned char* p) { return __builtin_amdgcn_ds_read_tr16_b64_v4i16((LAS s16x4*)p); }
__device__ __forceinline__ f32x4 mfma16(bf16x8 a, bf16x8 b, f32x4 c) { return __builtin_amdgcn_mfma_f32_16x16x32_bf16(a, b, c, 0, 0, 0); }

namespace pg8 {
constexpr int BM = 256, BK = 64, HALF = 128, HTB = HALF * BK * 2, STAGE_BYTES = 8 * HTB, NXCD = 8, WGM = 8;
__host__ __device__ __forceinline__ int lds_byte(int r, int c) { const int st = (r >> 4) * 2 + (c >> 5), rr = r & 15, cc = c & 31, ob = rr * 64 + cc * 2; return st * 1024 + (ob ^ (((ob >> 9) & 1) << 5)); }
__host__ __device__ __forceinline__ void stage_rc(int b, int& R, int& C) { const int st = b / 1024, sb = b % 1024, swz = sb ^ (((sb >> 9) & 1) << 5); R = (st >> 1) * 16 + swz / 64; C = (st & 1) * 32 + (swz % 64) / 2; }
__host__ __device__ __forceinline__ int perm32(int rho) { const int n = rho >> 4, i = rho & 15; return 8 * (i >> 2) + 4 * n + (i & 3); }
struct Unit { int pm, pn, i; };
struct Gemm { const bf16_t* A; const bf16_t* Bt; int M, N, K, ldA, ldB, splitk; size_t kstepA, kstepB; };
struct StaticOrder {
    int nM, nN, nwg, G, c;
    __host__ __device__ void init(int M, int N, int G_, int c_) { nM = M / BM; nN = N / BM; nwg = nM * nN; G = G_; c = c_; }
    __host__ __device__ bool next(int i, Unit& u) const {
        const long L = (long)i * G + c; if (L >= nwg) return false;
        int wgid = (int)L; { const int q = nwg / NXCD, r = nwg % NXCD, xcd = wgid % NXCD, off = wgid / NXCD; wgid = (xcd < r ? xcd * (q + 1) : r * (q + 1) + (xcd - r) * q) + off; }
        const int nig = WGM * nN, gid = wgid / nig, fm = gid * WGM, gsz = (nM - fm) < WGM ? (nM - fm) : WGM;
        u.pm = fm + ((wgid % nig) % gsz); u.pn = (wgid % nig) / gsz; return true;
    }
    __device__ __forceinline__ void a_ready(const Unit&) const {}
    __device__ __forceinline__ void done(const Unit&) const {}
};

template <class Epi, class Sched, bool ALIGN_EPI = false, bool SP2 = false>
__device__ __forceinline__ void gemm_phase(LAS unsigned char* lds, const Gemm g, const Sched& S, const Epi& E) {
    int tid_ = threadIdx.x; asm volatile("" : "+v"(tid_));
    const int tid = tid_, wid = __builtin_amdgcn_readfirstlane(tid >> 6), lane = tid & 63, wr = wid >> 2, wc = wid & 3, fr = lane & 15, fq = lane >> 4;
    const int K = g.K, nt = K / BK, LDA = g.ldA, LDB = g.ldB;
    unsigned voffA[2], voffB[2];
#pragma unroll
    for (int i = 0; i < 2; ++i) { int R, C; stage_rc(tid * 16 + i * 8192, R, C); const int Rb = Epi::PERM ? ((R & ~31) + perm32(R & 31)) : R;
        voffA[i] = (unsigned)(R * LDA + C) * 2u; voffB[i] = (unsigned)(Rb * LDB + C) * 2u; }
    const size_t kstepA = g.kstepA, kstepB = g.kstepB;
    const size_t hstepA = (size_t)HALF * LDA * 2, hstepB = (size_t)HALF * LDB * 2;
    const size_t tstepA = 2 * hstepA, tstepB = 2 * hstepB;
    const unsigned ldsw = (unsigned)wid * 1024u;
    const int aoff = lds_byte(wr * 64 + fr, fq * 8), boff = lds_byte(wc * 32 + fr, fq * 8);
#define PG8_SA(b, h) (((b) * 2 + (h)) * HTB)
#define PG8_SB(b, h) ((4 + (b) * 2 + (h)) * HTB)
#define PG8_STAGE(bufoff, gbase, voff) do { _Pragma("unroll") for (int _i = 0; _i < 2; ++_i) \
        __builtin_amdgcn_global_load_lds((const unsigned*)((const char*)(gbase) + (voff)[_i]), (LAS unsigned*)(lds + (bufoff) + ldsw + _i * 8192), 16, 0, 0); } while (0)
#define PG8_LDA(dst, b, h) do { _Pragma("unroll") for (int m = 0; m < 4; ++m) _Pragma("unroll") for (int k = 0; k < 2; ++k) dst[m][k] = *(const LAS bf16x8*)(lds + PG8_SA(b, h) + aoff + m * 2048 + k * 1024); } while (0)
#define PG8_LDB(dst, b, h) do { _Pragma("unroll") for (int n = 0; n < 2; ++n) _Pragma("unroll") for (int k = 0; k < 2; ++k) dst[n][k] = *(const LAS bf16x8*)(lds + PG8_SB(b, h) + boff + n * 2048 + k * 1024); } while (0)
#define PG8_MMA(ai, bj, At, Bt) do { __builtin_amdgcn_s_setprio(1); _Pragma("unroll") for (int m = 0; m < 4; ++m) _Pragma("unroll") for (int n = 0; n < 2; ++n) _Pragma("unroll") for (int k = 0; k < 2; ++k) \
        acc[ai][bj][m][n] = __builtin_amdgcn_mfma_f32_16x16x32_bf16(Bt[n][k], At[m][k], acc[ai][bj][m][n], 0, 0, 0); __builtin_amdgcn_s_setprio(0); } while (0)
#define PG8_WAIT_V(n) asm volatile("s_waitcnt vmcnt(" #n ")" ::: "memory")
#define PG8_WAIT_L(n) asm volatile("s_waitcnt lgkmcnt(" #n ")" ::: "memory")
#define PG8_BAR __builtin_amdgcn_s_barrier()
#define PG8_SCHED __builtin_amdgcn_sched_barrier(0)
    Unit cur, nxt; int ui = 0;
    if (!S.next(0, cur)) return;
    cur.i = 0;
    f32x4 acc[2][2][4][2];
    E.init(acc, cur, wr, wc, fr, fq);
    bf16x8 At[4][2], B0[2][2], B1[2][2];
    const size_t ksliceA = (size_t)nt * g.kstepA, ksliceB = (size_t)nt * g.kstepB;
    const char* cA = (const char*)g.A + (size_t)cur.pm * tstepA + (g.splitk ? cur.pn * ksliceA : 0); const char* cB = (const char*)g.Bt + (g.splitk ? cur.pn * ksliceB : (size_t)cur.pn * tstepB);
    S.a_ready(cur);
    if constexpr (SP2) {
        PG8_STAGE(PG8_SB(0, 0), cB, voffB); PG8_STAGE(PG8_SB(0, 1), cB + hstepB, voffB); PG8_STAGE(PG8_SA(0, 0), cA, voffA); PG8_STAGE(PG8_SA(0, 1), cA + hstepA, voffA);
        if (wr == 1) PG8_BAR;
        PG8_WAIT_V(2); PG8_BAR;
        PG8_STAGE(PG8_SB(1, 0), cB + kstepB, voffB); PG8_STAGE(PG8_SA(1, 0), cA + kstepA, voffA); PG8_STAGE(PG8_SB(1, 1), cB + hstepB + kstepB, voffB);
        PG8_WAIT_V(6); PG8_BAR;
    } else {
        PG8_STAGE(PG8_SB(0, 0), cB, voffB); PG8_STAGE(PG8_SA(0, 0), cA, voffA); PG8_STAGE(PG8_SB(0, 1), cB + hstepB, voffB); PG8_STAGE(PG8_SA(0, 1), cA + hstepA, voffA);
        if (wr == 1) PG8_BAR;
        PG8_WAIT_V(4); PG8_BAR;
        PG8_STAGE(PG8_SB(1, 0), cB + kstepB, voffB); PG8_STAGE(PG8_SA(1, 0), cA + kstepA, voffA); PG8_STAGE(PG8_SB(1, 1), cB + hstepB + kstepB, voffB);
        PG8_WAIT_V(6); PG8_BAR;
    }
    for (;;) {
        const bool has_next = S.next(ui + 1, nxt);
        nxt.i = ui + 1;
        const char* nA = has_next ? (const char*)g.A + (size_t)nxt.pm * tstepA + (g.splitk ? nxt.pn * ksliceA : 0) : cA; const char* nB = has_next ? (const char*)g.Bt + (g.splitk ? nxt.pn * ksliceB : (size_t)nxt.pn * tstepB) : cB;
        for (int t = 0; t < nt; t += 2) {
            const bool last = (t == nt - 2);
            const char* a1 = cA + (size_t)(t + 1) * kstepA;
            const char* a2 = last ? nA : cA + (size_t)(t + 2) * kstepA; const char* b2 = last ? nB : cB + (size_t)(t + 2) * kstepB;
            const char* a3 = a2 + kstepA; const char* b3 = b2 + kstepB;
            if (last && has_next) S.a_ready(nxt);
            if constexpr (SP2) {
            PG8_LDB(B0, 0, 0); PG8_LDB(B1, 0, 1); PG8_SCHED; PG8_LDA(At, 0, 0); PG8_STAGE(PG8_SA(1, 1), a1 + hstepA, voffA);
            PG8_WAIT_V(8); PG8_WAIT_L(0); PG8_BAR; PG8_MMA(0, 0, At, B0); PG8_MMA(0, 1, At, B1); PG8_BAR; PG8_SCHED;
            PG8_LDA(At, 0, 1); PG8_STAGE(PG8_SB(0, 0), b2, voffB); PG8_STAGE(PG8_SB(0, 1), b2 + hstepB, voffB); PG8_STAGE(PG8_SA(0, 0), a2, voffA);
            PG8_WAIT_V(8); PG8_WAIT_L(0); PG8_BAR; PG8_MMA(1, 0, At, B0); PG8_MMA(1, 1, At, B1); PG8_BAR; PG8_SCHED;
            PG8_LDB(B0, 1, 0); PG8_LDB(B1, 1, 1); PG8_SCHED; PG8_LDA(At, 1, 0); PG8_STAGE(PG8_SA(0, 1), a2 + hstepA, voffA);
            PG8_WAIT_V(8); PG8_WAIT_L(0); PG8_BAR; PG8_MMA(0, 0, At, B0); PG8_MMA(0, 1, At, B1); PG8_BAR; PG8_SCHED;
            PG8_LDA(At, 1, 1); PG8_STAGE(PG8_SB(1, 0), b3, voffB); PG8_STAGE(PG8_SB(1, 1), b3 + hstepB, voffB); PG8_STAGE(PG8_SA(1, 0), a3, voffA);
            PG8_WAIT_V(8); PG8_WAIT_L(0); PG8_BAR; PG8_MMA(1, 0, At, B0); PG8_MMA(1, 1, At, B1); PG8_BAR; PG8_SCHED;
            } else {
            PG8_LDB(B0, 0, 0); PG8_SCHED; PG8_LDA(At, 0, 0); PG8_STAGE(PG8_SA(1, 1), a1 + hstepA, voffA);
            PG8_WAIT_L(8); PG8_BAR; PG8_WAIT_L(0); PG8_MMA(0, 0, At, B0); PG8_BAR; PG8_SCHED;
            PG8_LDB(B1, 0, 1); PG8_STAGE(PG8_SB(0, 0), b2, voffB);
            PG8_BAR; PG8_WAIT_L(0); PG8_MMA(0, 1, At, B1); PG8_BAR;
            PG8_LDA(At, 0, 1); PG8_STAGE(PG8_SA(0, 0), a2, voffA);
            PG8_BAR; PG8_WAIT_L(0); PG8_MMA(1, 0, At, B0); PG8_BAR; PG8_SCHED;
            PG8_STAGE(PG8_SB(0, 1), b2 + hstepB, voffB);
            PG8_WAIT_V(6); PG8_BAR; PG8_MMA(1, 1, At, B1); PG8_BAR;
            PG8_LDB(B0, 1, 0); PG8_SCHED; PG8_LDA(At, 1, 0); PG8_STAGE(PG8_SA(0, 1), a2 + hstepA, voffA);
            PG8_WAIT_L(8); PG8_BAR; PG8_WAIT_L(0); PG8_MMA(0, 0, At, B0); PG8_BAR; PG8_SCHED;
            PG8_LDB(B1, 1, 1); PG8_STAGE(PG8_SB(1, 0), b3, voffB);
            PG8_BAR; PG8_WAIT_L(0); PG8_MMA(0, 1, At, B1); PG8_BAR;
            PG8_LDA(At, 1, 1); PG8_STAGE(PG8_SA(1, 0), a3, voffA);
            PG8_BAR; PG8_WAIT_L(0); PG8_MMA(1, 0, At, B0); PG8_BAR; PG8_SCHED;
            PG8_STAGE(PG8_SB(1, 1), b3 + hstepB, voffB);
            PG8_WAIT_V(6); PG8_BAR; PG8_MMA(1, 1, At, B1); PG8_BAR;
            }
        }
        if constexpr (ALIGN_EPI) { if (wr == 0) PG8_BAR; }
        E(acc, cur, wr, wc, fr, fq);
        if (!has_next) break;
        E.init(acc, nxt, wr, wc, fr, fq);
        cur = nxt; cA = nA; cB = nB; ++ui;
        if constexpr (ALIGN_EPI) { if (wr == 1) PG8_BAR; }
    }
    PG8_WAIT_V(0);
    if constexpr (!ALIGN_EPI) { if (wr == 0) PG8_BAR; }
    PG8_BAR;
#undef PG8_SA
#undef PG8_SB
#undef PG8_STAGE
#undef PG8_LDA
#undef PG8_LDB
#undef PG8_MMA
#undef PG8_WAIT_V
#undef PG8_WAIT_L
#undef PG8_BAR
#undef PG8_SCHED
}
}
using pg8::Unit;

typedef f32x4 AccT[2][2][4][2];

__device__ __forceinline__ void rope8(f32x4& v0, f32x4& v1, const f32x2* tab_) {
    const GAS f32x2* tab = (const GAS f32x2*)tab_;
    f32x2 c0 = tab[0], c1 = tab[1], c2 = tab[2], c3 = tab[3];
    float a, b;
    a = v0[0]; b = v0[1]; v0[0] = a * c0.x - b * c0.y; v0[1] = a * c0.y + b * c0.x;
    a = v0[2]; b = v0[3]; v0[2] = a * c1.x - b * c1.y; v0[3] = a * c1.y + b * c1.x;
    a = v1[0]; b = v1[1]; v1[0] = a * c2.x - b * c2.y; v1[1] = a * c2.y + b * c2.x;
    a = v1[2]; b = v1[3]; v1[2] = a * c3.x - b * c3.y; v1[3] = a * c3.y + b * c3.x;
}


typedef f32x4 AccT_[2][2][4][2];
__device__ __forceinline__ void acc_zero(AccT_& acc) {
#pragma unroll
    for (int a = 0; a < 2; ++a)
#pragma unroll
        for (int b = 0; b < 2; ++b)
#pragma unroll
            for (int m = 0; m < 4; ++m)
#pragma unroll
                for (int n = 0; n < 2; ++n) acc[a][b][m][n] = (f32x4){0.f, 0.f, 0.f, 0.f};
}
constexpr int RSTD_LDS_OFF = 131072;
template <int NS>
__device__ __forceinline__ void fill_rstd(LAS unsigned char* lds, const float* ss, float invn, const pg8::StaticOrder& S) {
    int tid = threadIdx.x; asm volatile("" : "+v"(tid));
    LAS float* dst = (LAS float*)(lds + RSTD_LDS_OFF);
    if (tid < 256) {
        float sum[4]; bool have[4];
#pragma unroll
        for (int i = 0; i < 4; ++i) {
            Unit u; have[i] = S.next(i, u); sum[i] = 0.f;
            if (have[i]) {
                const float* q = ss + (size_t)(u.pm * 256 + tid) * NS;
#pragma unroll
                for (int k = 0; k < NS; k += 4) { const f32x4 v = *(const GAS f32x4*)(q + k); sum[i] += (v[0] + v[1]) + (v[2] + v[3]); }
            }
        }
#pragma unroll
        for (int i = 0; i < 4; ++i) if (have[i]) dst[i * 256 + tid] = rsqrtf(sum[i] * invn + EPS);
    }
    __syncthreads();
}
__device__ __forceinline__ float lds_rstd(int ui, int r) { return *(const LAS float*)((LAS unsigned char*)nullptr + RSTD_LDS_OFF + (ui * 256 + r) * 4); }

__device__ __forceinline__ void rope8_calc(f32x4& v0, f32x4& v1, float posf, const float (&inv)[4]) {
    float c[4], s[4];
#pragma unroll
    for (int p2 = 0; p2 < 4; ++p2) { const float rev = __builtin_amdgcn_fractf(posf * inv[p2]); s[p2] = __builtin_amdgcn_sinf(rev); c[p2] = __builtin_amdgcn_cosf(rev); }
    float a, b;
    a = v0[0]; b = v0[1]; v0[0] = a * c[0] - b * s[0]; v0[1] = a * s[0] + b * c[0];
    a = v0[2]; b = v0[3]; v0[2] = a * c[1] - b * s[1]; v0[3] = a * s[1] + b * c[1];
    a = v1[0]; b = v1[1]; v1[0] = a * c[2] - b * s[2]; v1[1] = a * s[2] + b * c[2];
    a = v1[2]; b = v1[3]; v1[2] = a * c[3] - b * s[3]; v1[3] = a * s[3] + b * c[3];
}
__device__ __forceinline__ void rope_inv4(int i0, float rhalf, float (&inv)[4]) {
#pragma unroll
    for (int p2 = 0; p2 < 4; ++p2) inv[p2] = __builtin_amdgcn_exp2f(-(float)(i0 + p2) * (13.287712379549449f * rhalf)) * 0.15915494309189535f;
}

__device__ __forceinline__ size_t xb_off(int row, int c) { return ((size_t)(c >> 6) * T + row) * 64 + (c & 63); }

struct EpiIn {
    static constexpr bool PERM = true;
    __device__ __forceinline__ void init(AccT_& acc, const Unit&, int, int, int, int) const { acc_zero(acc); }
    const float* ssx; bf16_t* cq; bf16_t* ckv; float* mraw; bf16_t* mv; bf16_t* mo; bf16_t* krope; float* gates; float* sscq; float* ssckv; const f32x2* ropeA;
    __device__ __forceinline__ void operator()(const AccT& acc, const Unit& u, int wr, int wc, int fr, int fq) const {
        asm volatile("" : "+v"(fr), "+v"(fq));
        const int pn = u.pn;
#pragma unroll
        for (int ai = 0; ai < 2; ++ai)
#pragma unroll
            for (int m = 0; m < 4; ++m) {
                asm volatile("" ::: "memory");
                const int row = u.pm * 256 + ai * 128 + wr * 64 + m * 16 + fr;
                const float rs = lds_rstd(u.i, ai * 128 + wr * 64 + m * 16 + fr);
                float ssq = 0.f;
#pragma unroll
                for (int bj = 0; bj < 2; ++bj) {
                    const int cl = bj * 128 + wc * 32 + fq * 8;
                    f32x4 v0 = acc[ai][bj][m][0] * rs, v1 = acc[ai][bj][m][1] * rs;
                    if (pn < 4) {
                        bf16_t* dst = (pn < 2 ? cq : ckv) + xb_off(row, (pn & 1) * 256 + cl);
                        *(GAS u32x4*)dst = pk8(v0, v1);
                        ssq += (v0[0] * v0[0] + v0[1] * v0[1]) + (v0[2] * v0[2] + v0[3] * v0[3]) + (v1[0] * v1[0] + v1[1] * v1[1]) + (v1[2] * v1[2] + v1[3] * v1[3]);
                    } else if (pn < 8) {
                        float* dst = mraw + (size_t)row * 1024 + (pn - 4) * 256 + cl;
                        *(GAS f32x4*)dst = v0; *(GAS f32x4*)(dst + 4) = v1;
                    } else if (pn < 12) {
                        *(GAS u32x4*)(mv + (size_t)row * 1024 + (pn - 8) * 256 + cl) = pk8(v0, v1);
                    } else if (pn < 16) {
#pragma unroll
                        for (int e = 0; e < 4; ++e) { v0[e] = sigmoidf_(v0[e]); v1[e] = sigmoidf_(v1[e]); }
                        *(GAS u32x4*)(mo + (size_t)row * 1024 + (pn - 12) * 256 + cl) = pk8(v0, v1);
                    } else {
                        if (bj == 0) {
                            if (wc < 2) {
                                const int pos = row & (SEQ - 1);
                                rope8(v0, v1, ropeA + pos * 32 + (cl >> 1));
                                *(GAS u32x4*)(krope + (size_t)row * 64 + cl) = pk8(v0, v1);
                            } else if (wc == 2 && fq == 0) {
                                *(GAS f32x4*)(gates + (size_t)row * 8) = v0; *(GAS f32x4*)(gates + (size_t)row * 8 + 4) = v1;
                            }
                        }
                    }
                }
                if (pn < 4) {
                    ssq += __shfl_xor(ssq, 16); ssq += __shfl_xor(ssq, 32);
                    if (fq == 0) *(GAS float*)((pn < 2 ? sscq : ssckv) + (size_t)row * 8 + (pn & 1) * 4 + wc) = ssq;
                }
            }
    }
};

struct EpiUQ {
    static constexpr bool PERM = true;
    __device__ __forceinline__ void init(AccT_& acc, const Unit&, int, int, int, int) const { acc_zero(acc); }
    const float* sscq; bf16_t* qb; const f32x2* ropeA;
    __device__ __forceinline__ void operator()(const AccT& acc, const Unit& u, int wr, int wc, int fr, int fq) const {
        asm volatile("" : "+v"(fr), "+v"(fq));
        const int pn = u.pn;
        const float qs = 0.07216878364870322f * LOG2E;
        float inv[2][4];
#pragma unroll
        for (int bj = 0; bj < 2; ++bj) rope_inv4(((bj * 128 + wc * 32 + fq * 8) & 63) >> 1, 1.0f / 32.0f, inv[bj]);
#pragma unroll
        for (int ai = 0; ai < 2; ++ai)
#pragma unroll
            for (int m = 0; m < 4; ++m) {
                asm volatile("" ::: "memory");
                const int row = u.pm * 256 + ai * 128 + wr * 64 + m * 16 + fr;
                const float rs = lds_rstd(u.i, ai * 128 + wr * 64 + m * 16 + fr) * qs;
#pragma unroll
                for (int bj = 0; bj < 2; ++bj) {
                    const int cl = bj * 128 + wc * 32 + fq * 8;
                    f32x4 v0 = acc[ai][bj][m][0] * rs, v1 = acc[ai][bj][m][1] * rs;
                    if (pn < 4) {
                        *(GAS u32x4*)(qb + (size_t)row * 1536 + pn * 256 + cl) = pk8(v0, v1);
                    } else {
                        const int cr = (pn - 4) * 256 + cl;
                        rope8_calc(v0, v1, (float)(row & (SEQ - 1)), inv[bj]);
                        *(GAS u32x4*)(qb + (size_t)row * 1536 + 1024 + cr) = pk8(v0, v1);
                    }
                }
            }
    }
};

struct EpiUKV {
    static constexpr bool PERM = true;
    __device__ __forceinline__ void init(AccT_& acc, const Unit&, int, int, int, int) const { acc_zero(acc); }
    const float* ssckv; bf16_t* knope; bf16_t* vb;
    __device__ __forceinline__ void operator()(const AccT& acc, const Unit& u, int wr, int wc, int fr, int fq) const {
        asm volatile("" : "+v"(fr), "+v"(fq));
        const int pn = u.pn;
#pragma unroll
        for (int ai = 0; ai < 2; ++ai)
#pragma unroll
            for (int m = 0; m < 4; ++m) {
                asm volatile("" ::: "memory");
                const int row = u.pm * 256 + ai * 128 + wr * 64 + m * 16 + fr;
                const float rs = lds_rstd(u.i, ai * 128 + wr * 64 + m * 16 + fr);
#pragma unroll
                for (int bj = 0; bj < 2; ++bj) {
                    const int cl = bj * 128 + wc * 32 + fq * 8;
                    f32x4 v0 = acc[ai][bj][m][0] * rs, v1 = acc[ai][bj][m][1] * rs;
                    bf16_t* dst = (pn < 4 ? knope + (size_t)row * 1024 + pn * 256 : vb + (size_t)row * 1024 + (pn - 4) * 256) + cl;
                    *(GAS u32x4*)dst = pk8(v0, v1);
                }
            }
    }
};

struct EpiQKV {
    static constexpr bool PERM = true;
    __device__ __forceinline__ void init(AccT_& acc, const Unit&, int, int, int, int) const { acc_zero(acc); }
    const float* ssx; bf16_t* qkv; const f32x2* ropeB;
    __device__ __forceinline__ void operator()(const AccT& acc, const Unit& u, int wr, int wc, int fr, int fq) const {
        asm volatile("" : "+v"(fr), "+v"(fq));
        const int pn = u.pn;
        const float qs = 0.08838834764831845f * LOG2E;
        float inv[2][4];
#pragma unroll
        for (int bj = 0; bj < 2; ++bj) rope_inv4(((bj * 128 + wc * 32 + fq * 8) & 127) >> 1, 1.0f / 64.0f, inv[bj]);
#pragma unroll
        for (int ai = 0; ai < 2; ++ai)
#pragma unroll
            for (int m = 0; m < 4; ++m) {
                asm volatile("" ::: "memory");
                const int row = u.pm * 256 + ai * 128 + wr * 64 + m * 16 + fr;
                float rs = lds_rstd(u.i, ai * 128 + wr * 64 + m * 16 + fr);
                if (pn < 8) rs *= qs;
#pragma unroll
                for (int bj = 0; bj < 2; ++bj) {
                    const int cl = bj * 128 + wc * 32 + fq * 8, c = pn * 256 + cl;
                    f32x4 v0 = acc[ai][bj][m][0] * rs, v1 = acc[ai][bj][m][1] * rs;
                    if (pn < 16) rope8_calc(v0, v1, (float)(row & (SEQ - 1)), inv[bj]);
                    *(GAS u32x4*)(qkv + (size_t)row * 6144 + c) = pk8(v0, v1);
                }
            }
    }
};

struct EpiRes {
    static constexpr bool PERM = true;
    bf16_t* xb; float* ssx;
    __device__ __forceinline__ void init(AccT_& acc, const Unit& u, int wr, int wc, int fr, int fq) const {
        asm volatile("" : "+v"(fr), "+v"(fq));
#pragma unroll
        for (int ai = 0; ai < 2; ++ai)
#pragma unroll
            for (int m = 0; m < 4; ++m)
#pragma unroll
                for (int bj = 0; bj < 2; ++bj) {
                    const u32x4 w = *(const GAS u32x4*)(xb + xb_off(u.pm * 256 + ai * 128 + wr * 64 + m * 16 + fr, u.pn * 256 + bj * 128 + wc * 32 + fq * 8));
                    acc[ai][bj][m][0] = (f32x4){bflo(w.x), bfhi(w.x), bflo(w.y), bfhi(w.y)}; acc[ai][bj][m][1] = (f32x4){bflo(w.z), bfhi(w.z), bflo(w.w), bfhi(w.w)};
                }
    }
    __device__ __forceinline__ void operator()(const AccT& acc, const Unit& u, int wr, int wc, int fr, int fq) const {
        asm volatile("" : "+v"(fr), "+v"(fq));
        const int pn = u.pn;
#pragma unroll
        for (int ai = 0; ai < 2; ++ai)
#pragma unroll
            for (int m = 0; m < 4; ++m) {
                asm volatile("" ::: "memory");
                const int row = u.pm * 256 + ai * 128 + wr * 64 + m * 16 + fr;
                float ssq = 0.f;
#pragma unroll
                for (int bj = 0; bj < 2; ++bj) {
                    const int c = pn * 256 + bj * 128 + wc * 32 + fq * 8;
                    const u32x4 w = pk8(acc[ai][bj][m][0], acc[ai][bj][m][1]);
                    *(GAS u32x4*)(xb + xb_off(row, c)) = w;
                    const float a0 = bflo(w.x), a1 = bfhi(w.x), a2 = bflo(w.y), a3 = bfhi(w.y), a4 = bflo(w.z), a5 = bfhi(w.z), a6 = bflo(w.w), a7 = bfhi(w.w);
                    ssq += (a0 * a0 + a1 * a1) + (a2 * a2 + a3 * a3) + (a4 * a4 + a5 * a5) + (a6 * a6 + a7 * a7);
                }
                ssq += __shfl_xor(ssq, 16); ssq += __shfl_xor(ssq, 32);
                if (fq == 0) *(GAS float*)(ssx + (size_t)row * 32 + pn * 4 + wc) = ssq;
            }
    }
};

struct EpiRelu2 {
    static constexpr bool PERM = true;
    __device__ __forceinline__ void init(AccT_& acc, const Unit&, int, int, int, int) const { acc_zero(acc); }
    const float* ssx; bf16_t* ub;
    __device__ __forceinline__ void operator()(const AccT& acc, const Unit& u, int wr, int wc, int fr, int fq) const {
        asm volatile("" : "+v"(fr), "+v"(fq));
        const int pn = u.pn;
#pragma unroll
        for (int ai = 0; ai < 2; ++ai)
#pragma unroll
            for (int m = 0; m < 4; ++m) {
                asm volatile("" ::: "memory");
                const int row = u.pm * 256 + ai * 128 + wr * 64 + m * 16 + fr;
                const float rs = lds_rstd(u.i, ai * 128 + wr * 64 + m * 16 + fr);
#pragma unroll
                for (int bj = 0; bj < 2; ++bj) {
                    const int c = pn * 256 + bj * 128 + wc * 32 + fq * 8;
                    f32x4 v0 = acc[ai][bj][m][0] * rs, v1 = acc[ai][bj][m][1] * rs;
#pragma unroll
                    for (int e = 0; e < 4; ++e) { float a = fmaxf(v0[e], 0.f), b = fmaxf(v1[e], 0.f); v0[e] = a * a; v1[e] = b * b; }
                    *(GAS u32x4*)(ub + ((size_t)(c >> 6) * T + row) * 64 + (c & 63)) = pk8(v0, v1);
                }
            }
    }
};

template <int NS, class Epi>
__device__ __forceinline__ void run_gemm(LAS unsigned char* lds, const bf16_t* A, const bf16_t* Bt, int N, int K, const Epi& E, const float* ss = nullptr, bool kblocked = false, int wrows_ = 0) {
    const int wrows = wrows_ ? wrows_ : N;
    pg8::Gemm g; g.A = A; g.Bt = Bt; g.M = T; g.N = N; g.K = K; g.splitk = 0;
    g.ldB = 64; g.kstepB = (size_t)wrows * 128;
    g.ldA = K; g.kstepA = 128;
    if (kblocked) { g.ldA = 64; g.kstepA = (size_t)T * 128; }
    int cblk = (int)blockIdx.x; asm volatile("" : "+s"(cblk));
    pg8::StaticOrder S; S.init(T, N, (int)gridDim.x, cblk);
    if constexpr (NS > 0) fill_rstd<NS>(lds, ss, NS == 32 ? 1.0f / 2048.0f : 1.0f / 512.0f, S);
    pg8::gemm_phase<Epi, pg8::StaticOrder, true, true>(lds, g, S, E);
}

struct EpiPart {
    static constexpr bool PERM = true;
    float* part;
    __device__ __forceinline__ void init(AccT_& acc, const Unit&, int, int, int, int) const { acc_zero(acc); }
    __device__ __forceinline__ void operator()(const AccT& acc, const Unit& u, int wr, int wc, int fr, int fq) const {
        asm volatile("" : "+v"(fr), "+v"(fq));
        const int cl = wc * 32 + fq * 8;
        if (cl < 72) {
#pragma unroll
            for (int ai = 0; ai < 2; ++ai)
#pragma unroll
                for (int m = 0; m < 4; ++m) {
                    const int row = u.pm * 256 + ai * 128 + wr * 64 + m * 16 + fr;
                    float* dst = part + ((size_t)u.pn * T + row) * 72 + cl;
                    *(GAS f32x4*)dst = acc[ai][0][m][0]; *(GAS f32x4*)(dst + 4) = acc[ai][0][m][1];
                }
        }
    }
};
__device__ __forceinline__ void run_gemm_splitk(LAS unsigned char* lds, const bf16_t* A, const bf16_t* Bt_tile, const EpiPart& E) {
    pg8::Gemm g; g.A = A; g.Bt = Bt_tile; g.M = T; g.N = 2048; g.K = 256; g.splitk = 1; g.ldA = 64; g.kstepA = (size_t)T * 128; g.ldB = 64; g.kstepB = (size_t)NIN * 128;
    int cblk = (int)blockIdx.x; asm volatile("" : "+s"(cblk));
    pg8::StaticOrder S; S.init(T, 2048, (int)gridDim.x, cblk);
    pg8::gemm_phase<EpiPart, pg8::StaticOrder, true, true>(lds, g, S, E);
}

__device__ __forceinline__ int dstmap(int id, int n) {
    switch (id) {
    case 1:
        if (n < 1024) return n;
        if (n < 1088) { const int r = n - 1024; return 4096 + (r < 32 ? 2 * r : 2 * (r - 32) + 1); }
        if (n < 2112) return 1024 + (n - 1088);
        if (n < 3136) return 2048 + (n - 2112);
        if (n < 3140) return 4160 + (n - 3136);
        if (n < 3144) return 4164 + (n - 3140);
        return 3072 + (n - 3144);
    case 2: { const int h = n / 192, d = n - h * 192; if (d < 128) return h * 128 + d; const int r = d - 128; return 1024 + h * 64 + (r < 32 ? 2 * r : 2 * (r - 32) + 1); }
    case 3: { const int h = n >> 8, e = n & 255; return (e < 128) ? h * 128 + e : 1024 + h * 128 + (e - 128); }
    case 4:
        if (n < 4096) { const int base = n & ~127, d = n & 127; return base + (d < 64 ? 2 * d : 2 * (d - 64) + 1); }
        return n;
    default: return n;
    }
}
__device__ __forceinline__ void prep_transpose(const float* W, int K, int Nsrc, int mapid, const float* gain, bf16_t* WT, LAS float* scr, int gw, int ngw, int lane, int blocked_rows = 0) {
    const int nblk = (Nsrc + 63) / 64, nitems = (K / 64) * nblk;
    const int q = lane & 15, r4 = lane >> 4;
    for (int it = gw; it < nitems; it += ngw) {
        const int kb = it / nblk, nb = it % nblk, k0 = 64 * kb, n0 = 64 * nb;
        const int ncol = n0 + 4 * q; const bool ok = ncol < Nsrc;
        f32x4 v[16];
#pragma unroll
        for (int i = 0; i < 16; ++i) v[i] = ok ? *(const GAS f32x4*)(W + (size_t)(k0 + 4 * i + r4) * Nsrc + ncol) : (f32x4){0.f, 0.f, 0.f, 0.f};
#pragma unroll
        for (int i = 0; i < 16; ++i) {
            const float g = gain ? gain[k0 + 4 * i + r4] : 1.0f;
            LAS float* d = scr + (4 * i + r4) * 65 + 4 * q;
            d[0] = v[i][0] * g; d[1] = v[i][1] * g; d[2] = v[i][2] * g; d[3] = v[i][3] * g;
        }
        asm volatile("s_waitcnt lgkmcnt(0)" ::: "memory");
        const int c = lane & 7;
#pragma unroll
        for (int j = 0; j < 8; ++j) {
            const int n = (lane >> 3) + 8 * j; const LAS float* s = scr + (8 * c) * 65 + n;
            u32x4 o; o.x = pk2(s[0 * 65], s[1 * 65]); o.y = pk2(s[2 * 65], s[3 * 65]); o.z = pk2(s[4 * 65], s[5 * 65]); o.w = pk2(s[6 * 65], s[7 * 65]);
            if (n0 + n < Nsrc) {
                const int dn = dstmap(mapid, n0 + n);
                bf16_t* dp = blocked_rows ? WT + ((size_t)(k0 >> 6) * blocked_rows + dn) * 64 + 8 * c : WT + (size_t)dn * K + k0 + 8 * c;
                *(GAS u32x4*)dp = o;
            }
        }
        asm volatile("s_waitcnt lgkmcnt(0)" ::: "memory");
    }
}

__device__ __forceinline__ void phase_prep(const Params& p, LAS unsigned char* lds) {
    const int tid = threadIdx.x, wave = tid >> 6, lane = tid & 63;
    const int gw = blockIdx.x * 8 + wave, ngw = gridDim.x * 8;
    LAS float* scr = (LAS float*)(lds + wave * 16640);
    unsigned char* ws = opaque_ws(p);
    for (int row = gw; row < T; row += ngw) {
        const GAS f32x4* xr = (const GAS f32x4*)(p.x + (size_t)row * DM) + lane;
        bf16_t* xbase = (bf16_t*)(ws + OFF_XB);
        float s = 0.f;
#pragma unroll
        for (int j = 0; j < 8; ++j) { f32x4 v = xr[64 * j]; u32x2 o; o.x = pk2(v[0], v[1]); o.y = pk2(v[2], v[3]); *(GAS u32x2*)(xbase + xb_off(row, 4 * (lane + 64 * j))) = o; const float a0 = bflo(o.x), a1 = bfhi(o.x), a2 = bflo(o.y), a3 = bfhi(o.y); s += (a0 * a0 + a1 * a1) + (a2 * a2 + a3 * a3); }
        s = wave_sum(s);
        if (lane < 32) ((GAS float*)(ws + OFF_SSX))[(size_t)row * 32 + lane] = (lane == 0) ? s : 0.f;
    }
    for (int l = 0; l < 2; ++l) {
        prep_transpose(p.ev_w_in + (size_t)l * 2048 * 4168, 2048, 4168, 1, p.norm_mix + (size_t)(2 * l) * DM, (bf16_t*)(ws + OFF_WIN + l * SZ_WIN), scr, gw, ngw, lane, NIN);
        prep_transpose(p.mla_w_uq + (size_t)l * 512 * 1536, 512, 1536, 2, p.mla_q_norm + l * 512, (bf16_t*)(ws + OFF_WUQ + l * SZ_WUQ), scr, gw, ngw, lane, 1536);
        prep_transpose(p.mla_w_ukv + (size_t)l * 512 * 2048, 512, 2048, 3, p.mla_kv_norm + l * 512, (bf16_t*)(ws + OFF_WUKV + l * SZ_WUKV), scr, gw, ngw, lane, 2048);
        prep_transpose(p.ev_w_out + (size_t)l * 2048 * 2048, 2048, 2048, 0, nullptr, (bf16_t*)(ws + OFF_WEVO + l * SZ_WO), scr, gw, ngw, lane, 2048);
        prep_transpose(p.od_w_qkv + (size_t)l * 2048 * 6144, 2048, 6144, 4, p.norm_mix + (size_t)(2 * l + 1) * DM, (bf16_t*)(ws + OFF_WQKV + l * SZ_WQKV), scr, gw, ngw, lane, 6144);
        prep_transpose(p.od_w_out + (size_t)l * 2048 * 2048, 2048, 2048, 0, nullptr, (bf16_t*)(ws + OFF_WODO + l * SZ_WO), scr, gw, ngw, lane, 2048);
    }
    for (int l = 0; l < 4; ++l) {
        prep_transpose(p.mlp_w1 + (size_t)l * 2048 * 8192, 2048, 8192, 0, p.norm_mlp + (size_t)l * DM, (bf16_t*)(ws + OFF_W1 + l * SZ_W1), scr, gw, ngw, lane, 8192);
        prep_transpose(p.mlp_w2 + (size_t)l * 8192 * 2048, 8192, 2048, 0, nullptr, (bf16_t*)(ws + OFF_W2 + l * SZ_W1), scr, gw, ngw, lane, 2048);
    }
}

struct AttnArgs {
    const bf16_t* q; const bf16_t* k0; const bf16_t* k1; const bf16_t* v;
    int h, tokbase, dil, qb, kt_begin, kt_end;
    bf16_t* out; int ostride, ooff; float* lse;
    int oblk;
};
template <int MODE>
__device__ __forceinline__ void attn_item(const AttnArgs& a, LAS unsigned char* lds) {
    constexpr bool MLA = (MODE == 0), TWO = (MODE == 2);
    constexpr int DQ = MLA ? 192 : 128, KST = DQ + 8, NKC = DQ / 32, VST = 144;
    constexpr int KB = 64 * KST * 2, VB = 64 * VST * 2;
    constexpr int NTH = TWO ? 256 : 512;
    constexpr int NKL = (64 * (DQ / 8)) / NTH, NVL = (64 * 16) / NTH;
    constexpr int QROWS = TWO ? 128 : 256;
    int tid = threadIdx.x; asm volatile("" : "+v"(tid));
    const int wave = __builtin_amdgcn_readfirstlane(tid >> 6), lane = tid & 63; int lq = lane & 15, quad = lane >> 4;
    const int strm = TWO ? (wave >> 2) : 0, rowbase = (TWO ? (wave & 3) : wave) * 32;
    const int stid = TWO ? (tid & 255) : tid;
    const int tokbase = a.tokbase + strm;
    LAS unsigned char* Kbuf0 = lds + strm * 2 * (KB + VB);
    const int qrow0 = a.qb * QROWS + rowbase;
    bf16x8 qf[2][NKC];
#pragma unroll
    for (int sub = 0; sub < 2; ++sub) {
        const size_t qtok = (size_t)(tokbase + (qrow0 + sub * 16 + lq) * a.dil);
#pragma unroll
        for (int kk = 0; kk < NKC; ++kk) {
            const int d0 = kk * 32 + quad * 8;
            const bf16_t* src;
            if (MLA) src = (d0 < 128) ? a.q + qtok * 1536 + a.h * 128 + d0 : a.q + qtok * 1536 + 1024 + a.h * 64 + (d0 - 128);
            else src = a.q + qtok * 6144 + a.h * 128 + d0;
            qf[sub][kk] = *(const GAS bf16x8*)src;
        }
    }
    float m[2] = {-1e30f, -1e30f}, l[2] = {0.f, 0.f};
    f32x4 o[2][8];
#pragma unroll
    for (int sub = 0; sub < 2; ++sub)
#pragma unroll
        for (int i = 0; i < 8; ++i) o[sub][i] = (f32x4){0.f, 0.f, 0.f, 0.f};
    u32x4 kreg[NKL], vreg[NVL];
    auto prefetch = [&](int kt) {
#pragma unroll
        for (int i = 0; i < NKL; ++i) {
            const int c = stid + NTH * i;
            if (MLA) {
                const int r = c / 24, cc = c % 24; const size_t tok = (size_t)(tokbase + (kt * 64 + r) * a.dil);
                const bf16_t* src = (cc < 16) ? a.k0 + tok * 1024 + a.h * 128 + cc * 8 : a.k1 + tok * 64 + (cc - 16) * 8;
                kreg[i] = *(const GAS u32x4*)src;
            } else {
                const int r = c >> 4, cc = c & 15; const size_t tok = (size_t)(tokbase + (kt * 64 + r) * a.dil);
                kreg[i] = *(const GAS u32x4*)(a.k0 + tok * 6144 + a.h * 128 + cc * 8);
            }
        }
#pragma unroll
        for (int i = 0; i < NVL; ++i) {
            const int c = stid + NTH * i, r = c >> 4, cc = c & 15; const size_t tok = (size_t)(tokbase + (kt * 64 + r) * a.dil);
            vreg[i] = *(const GAS u32x4*)(a.v + tok * (MLA ? 1024 : 6144) + a.h * 128 + cc * 8);
        }
    };
    auto stage = [&](LAS unsigned char* Kd) {
        LAS unsigned char* Vd = Kd + KB;
#pragma unroll
        for (int i = 0; i < NKL; ++i) {
            const int c = stid + NTH * i;
            const int r = MLA ? c / 24 : c >> 4, cc = MLA ? c % 24 : c & 15;
            *(LAS u32x4*)(Kd + (r * KST + cc * 8) * 2) = kreg[i];
        }
#pragma unroll
        for (int i = 0; i < NVL; ++i) { const int c = stid + NTH * i, r = c >> 4, cc = c & 15; *(LAS u32x4*)(Vd + (r * VST + cc * 8) * 2) = vreg[i]; }
    };
    prefetch(a.kt_begin);
    stage(Kbuf0);
    if (a.kt_begin + 1 < a.kt_end) prefetch(a.kt_begin + 1);
    __syncthreads();
    for (int kt = a.kt_begin; kt < a.kt_end; ++kt) {
        asm volatile("" : "+v"(lq), "+v"(quad), "+v"(tid));
        const int cur = (kt - a.kt_begin) & 1;
        LAS unsigned char* Ks = Kbuf0 + cur * (KB + VB);
        LAS unsigned char* Vs = Ks + KB;
        if (kt + 1 < a.kt_end) { stage(Kbuf0 + (cur ^ 1) * (KB + VB)); if (kt + 2 < a.kt_end) prefetch(kt + 2); }
        const int k0s = kt * 64;
        const bool dead = MLA ? (k0s > qrow0 + 31) : (k0s > qrow0 + 31 || k0s + 63 < qrow0 - 128);
        if (!dead) {
            f32x4 s[2][4];
            bf16x8 kfr[2][NKC];
            LAS unsigned char* kbase = Ks + (lq * KST + quad * 8) * 2;
#pragma unroll
            for (int kk = 0; kk < NKC; ++kk) kfr[0][kk] = *(const LAS bf16x8*)(kbase + kk * 64);
#pragma unroll
            for (int nt = 0; nt < 4; ++nt) {
                if (nt + 1 < 4) {
#pragma unroll
                    for (int kk = 0; kk < NKC; ++kk) kfr[(nt + 1) & 1][kk] = *(const LAS bf16x8*)(kbase + (nt + 1) * 16 * KST * 2 + kk * 64);
                }
                __builtin_amdgcn_sched_barrier(0);
                s[0][nt] = (f32x4){0.f, 0.f, 0.f, 0.f}; s[1][nt] = (f32x4){0.f, 0.f, 0.f, 0.f};
                __builtin_amdgcn_s_setprio(1);
#pragma unroll
                for (int kk = 0; kk < NKC; ++kk) {
                    s[0][nt] = mfma16(kfr[nt & 1][kk], qf[0][kk], s[0][nt]);
                    s[1][nt] = mfma16(kfr[nt & 1][kk], qf[1][kk], s[1][nt]);
                }
                __builtin_amdgcn_s_setprio(0);
                __builtin_amdgcn_sched_barrier(0);
            }
            bf16x8 vfr[2][4];
            LAS unsigned char* vbase = Vs + ((quad * 4 + (lq >> 2)) * VST + (lq & 3) * 4) * 2;
#pragma unroll
            for (int d4 = 0; d4 < 4; ++d4) vfr[0][d4] = mk8(lds_tr(vbase + d4 * 32), lds_tr(vbase + d4 * 32 + 16 * VST * 2));
            __builtin_amdgcn_sched_barrier(0);
            const bool needmask = MLA ? (k0s + 63 > qrow0) : true;
            bf16x8 pf[2][2];
#pragma unroll
            for (int sub = 0; sub < 2; ++sub) {
                if (needmask) {
                    const int ql = qrow0 + sub * 16 + lq;
#pragma unroll
                    for (int nt = 0; nt < 4; ++nt)
#pragma unroll
                        for (int jj = 0; jj < 4; ++jj) {
                            const int d = ql - (k0s + nt * 16 + quad * 4 + jj);
                            const bool valid = MLA ? (d >= 0) : (d >= 0 && d <= 128);
                            s[sub][nt][jj] = valid ? s[sub][nt][jj] : -1e30f;
                        }
                }
                float mx = -1e30f;
#pragma unroll
                for (int nt = 0; nt < 4; ++nt)
#pragma unroll
                    for (int jj = 0; jj < 4; ++jj) mx = fmaxf(mx, s[sub][nt][jj]);
                mx = fmaxf(mx, __shfl_xor(mx, 16)); mx = fmaxf(mx, __shfl_xor(mx, 32));
                const float mnew = fmaxf(m[sub], mx), alpha = __builtin_amdgcn_exp2f(m[sub] - mnew);
                float ps = 0.f;
#pragma unroll
                for (int nt = 0; nt < 4; ++nt)
#pragma unroll
                    for (int jj = 0; jj < 4; ++jj) { const float pv = __builtin_amdgcn_exp2f(s[sub][nt][jj] - mnew); s[sub][nt][jj] = pv; ps += pv; }
                l[sub] = l[sub] * alpha + ps; m[sub] = mnew;
#pragma unroll
                for (int i = 0; i < 8; ++i) o[sub][i] *= alpha;
#pragma unroll
                for (int k2 = 0; k2 < 2; ++k2) {
                    u32x4 w; w.x = pk2(s[sub][2 * k2][0], s[sub][2 * k2][1]); w.y = pk2(s[sub][2 * k2][2], s[sub][2 * k2][3]);
                    w.z = pk2(s[sub][2 * k2 + 1][0], s[sub][2 * k2 + 1][1]); w.w = pk2(s[sub][2 * k2 + 1][2], s[sub][2 * k2 + 1][3]);
                    pf[sub][k2] = __builtin_bit_cast(bf16x8, w);
                }
            }
            __builtin_amdgcn_sched_barrier(0);
#pragma unroll
            for (int bi = 0; bi < 4; ++bi) {
                if (bi + 1 < 4) {
                    const int k2n = (bi + 1) >> 1, dtn = ((bi + 1) & 1) * 4;
#pragma unroll
                    for (int d4 = 0; d4 < 4; ++d4) vfr[(bi + 1) & 1][d4] = mk8(lds_tr(vbase + k2n * 32 * VST * 2 + (dtn + d4) * 32), lds_tr(vbase + k2n * 32 * VST * 2 + (dtn + d4) * 32 + 16 * VST * 2));
                }
                __builtin_amdgcn_sched_barrier(0);
                const int k2 = bi >> 1, dt0 = (bi & 1) * 4;
                __builtin_amdgcn_s_setprio(1);
#pragma unroll
                for (int d4 = 0; d4 < 4; ++d4) {
                    o[0][dt0 + d4] = mfma16(vfr[bi & 1][d4], pf[0][k2], o[0][dt0 + d4]);
                    o[1][dt0 + d4] = mfma16(vfr[bi & 1][d4], pf[1][k2], o[1][dt0 + d4]);
                }
                __builtin_amdgcn_s_setprio(0);
                __builtin_amdgcn_sched_barrier(0);
            }
        }
        __syncthreads();
    }
#pragma unroll
    for (int sub = 0; sub < 2; ++sub) {
        float lt = l[sub];
        lt += __shfl_xor(lt, 16); lt += __shfl_xor(lt, 32);
        const float inv = 1.0f / lt;
        const size_t qtok = (size_t)(tokbase + (qrow0 + sub * 16 + lq) * a.dil);
        bf16_t* op = a.oblk ? a.out + xb_off((int)qtok, a.ooff) : a.out + qtok * a.ostride + a.ooff;
#pragma unroll
        for (int dt = 0; dt < 8; ++dt) {
            u32x2 w; w.x = pk2(o[sub][dt][0] * inv, o[sub][dt][1] * inv); w.y = pk2(o[sub][dt][2] * inv, o[sub][dt][3] * inv);
            *(GAS u32x2*)(op + (a.oblk ? (size_t)(dt >> 2) * T * 64 + (dt & 3) * 16 + quad * 4 : (size_t)(dt * 16 + quad * 4))) = w;
        }
        if (a.lse != nullptr && quad == 0) *(GAS float*)(a.lse + qtok * 16 + a.h) = m[sub] + __log2f(lt);
    }
}

__device__ __forceinline__ float logsigf_(float x) { return fminf(x, 0.f) - log1pf(__expf(-fabsf(x))); }

__device__ __forceinline__ void conv_silu8(const float* mraw, const float* convw, const float* convb, int b, int sp, int col, f32x4& y0, f32x4& y1) {
    y0 = *(const GAS f32x4*)(convb + col); y1 = *(const GAS f32x4*)(convb + col + 4);
#pragma unroll
    for (int jj = 0; jj < 4; ++jj) {
        const int s2 = sp - 3 + jj;
        if (s2 >= 0) {
            const float* r = mraw + (size_t)(b * SEQ + s2) * 1024 + col;
            const f32x4 x0 = *(const GAS f32x4*)r, x1 = *(const GAS f32x4*)(r + 4);
            const f32x4 w0 = *(const GAS f32x4*)(convw + jj * 1024 + col), w1 = *(const GAS f32x4*)(convw + jj * 1024 + col + 4);
            y0 += w0 * x0; y1 += w1 * x1;
        }
    }
#pragma unroll
    for (int e = 0; e < 4; ++e) { y0[e] = y0[e] * sigmoidf_(y0[e]); y1[e] = y1[e] * sigmoidf_(y1[e]); }
}

__device__ __forceinline__ void mlstm_A(const Params& p, int li, LAS unsigned char* lds, int item) {
    int tid = threadIdx.x; asm volatile("" : "+v"(tid));
    const int wave = __builtin_amdgcn_readfirstlane(tid >> 6), lane = tid & 63, lq = lane & 15, quad = lane >> 4;
    const int bh = item >> 4, c = item & 15, b = bh >> 2, h = bh & 3;
    constexpr int KPST = 144, VST = 272;
    LAS unsigned char* Kp = lds;
    LAS unsigned char* Vs = lds + 36864;
    LAS float* wkv = (LAS float*)(lds + 106496);
    unsigned char* ws = opaque_ws(p);
    const float* mraw = (const float*)(ws + OFF_MRAW);
    const bf16_t* mv = (const bf16_t*)(ws + OFF_MV);
    const float* gates = (const float*)(ws + OFF_GATES);
    bf16_t* mq = (bf16_t*)(ws + OFF_MQ); bf16_t* mk = (bf16_t*)(ws + OFF_MK);
    const float* convw = p.conv_w + (size_t)li * 4 * 1024;
    const float* convb = p.conv_b + (size_t)li * 1024;
    const float bi = p.b_i[li * 4 + h], bfv = p.b_f[li * 4 + h];
    const int tok0 = b * SEQ + c * 128;
    LAS float* gi = wkv + 128; LAS float* gf = gi + 128;
    __syncthreads();
    {
        const int row = tid >> 2, pt = tid & 3;
        const size_t tok = (size_t)(tok0 + row);
        const float* sp = (const float*)(ws + OFF_SSX) + tok * 32 + pt * 8;
        const f32x4 s0v = *(const GAS f32x4*)sp, s1v = *(const GAS f32x4*)(sp + 4);
        float ssq = ((s0v[0] + s0v[1]) + (s0v[2] + s0v[3])) + ((s1v[0] + s1v[1]) + (s1v[2] + s1v[3]));
        ssq += __shfl_xor(ssq, 1); ssq += __shfl_xor(ssq, 2);
        const float rs = rsqrtf(ssq * (1.0f / 2048.0f) + EPS);
        const float* pp = (const float*)(ws + OFF_PART) + tok * 72;
        f32x4 kv = (f32x4){0.f, 0.f, 0.f, 0.f}; float gsum = 0.f;
#pragma unroll
        for (int ks = 0; ks < 8; ++ks) {
            kv += *(const GAS f32x4*)(pp + (size_t)ks * T * 72 + 16 * h + 4 * pt);
            if (pt < 2) gsum += *(const GAS float*)(pp + (size_t)ks * T * 72 + 64 + 4 * pt + h);
        }
        kv *= rs; gsum *= rs;
        f32x2 c0, c1;
        {
            const float posf = (float)((int)tok & (SEQ - 1)), i0f = (float)(8 * h + 2 * pt);
            const float r0 = __builtin_amdgcn_fractf(posf * (__builtin_amdgcn_exp2f(-i0f * (13.287712379549449f / 32.0f)) * 0.15915494309189535f));
            const float r1 = __builtin_amdgcn_fractf(posf * (__builtin_amdgcn_exp2f(-(i0f + 1.0f) * (13.287712379549449f / 32.0f)) * 0.15915494309189535f));
            c0.x = __builtin_amdgcn_cosf(r0); c0.y = __builtin_amdgcn_sinf(r0); c1.x = __builtin_amdgcn_cosf(r1); c1.y = __builtin_amdgcn_sinf(r1);
        }
        u32x2 w2; w2.x = pk2(kv[0] * c0.x - kv[1] * c0.y, kv[0] * c0.y + kv[1] * c0.x); w2.y = pk2(kv[2] * c1.x - kv[3] * c1.y, kv[2] * c1.y + kv[3] * c1.x);
        *(GAS u32x2*)((bf16_t*)(ws + OFF_KROPE) + tok * 64 + 16 * h + 4 * pt) = w2;
        if (pt < 2) { *(GAS float*)((float*)(ws + OFF_GATES) + tok * 8 + 4 * pt + h) = gsum; (pt == 0 ? gi : gf)[row] = gsum; }
    }
    __syncthreads();
    if (wave == 0) {
        const int s0 = 2 * lane;
        const float i0 = gi[s0] + bi, f0 = gf[s0] + bfv, i1 = gi[s0 + 1] + bi, f1 = gf[s0 + 1] + bfv;
        const float lf0 = logsigf_(f0), lf1 = logsigf_(f1);
        const float p1 = lf0 + lf1; float incl = p1;
#pragma unroll
        for (int o = 1; o < 64; o <<= 1) { const float t = __shfl_up(incl, o); if (lane >= o) incl += t; }
        const float excl = incl - p1, b0 = excl + lf0, b1 = excl + p1;
        const float a0 = i0 - b0, a1 = i1 - b1;
        float am = fmaxf(a0, a1);
#pragma unroll
        for (int o = 1; o < 64; o <<= 1) am = fmaxf(am, __shfl_xor(am, o));
        const float bL = __int_as_float(__builtin_amdgcn_readlane(__float_as_int(b1), 63));
        wkv[s0] = __expf(a0 - am); wkv[s0 + 1] = __expf(a1 - am);
        if (lane == 0) { f32x2 sc; sc.x = am; sc.y = bL; ((GAS f32x2*)(ws + OFF_MSC))[item] = sc; }
    }
    __syncthreads();
#pragma unroll 2
    for (int i = 0; i < 4; ++i) {
        const int task = tid + 512 * i, row = task >> 4, cgp = task & 15;
        f32x4 y0, y1;
        conv_silu8(mraw, convw, convb, b, c * 128 + row, h * 128 + cgp * 8, y0, y1);
        *(GAS u32x4*)(mq + (size_t)(tok0 + row) * 512 + h * 128 + cgp * 8) = pk8(y0, y1);
        conv_silu8(mraw, convw, convb, b, c * 128 + row, 512 + h * 128 + cgp * 8, y0, y1);
        y0 *= 0.08838834764831845f; y1 *= 0.08838834764831845f;
        *(GAS u32x4*)(mk + (size_t)(tok0 + row) * 512 + h * 128 + cgp * 8) = pk8(y0, y1);
        const float wk = wkv[row];
        y0 *= wk; y1 *= wk;
        *(LAS u32x4*)(Kp + (row * KPST + cgp * 8) * 2) = pk8(y0, y1);
    }
#pragma unroll
    for (int i = 0; i < 8; ++i) {
        const int c2 = tid + 512 * i, row = c2 >> 5, ch = c2 & 31;
        *(LAS u32x4*)(Vs + (row * VST + ch * 8) * 2) = *(const GAS u32x4*)(mv + (size_t)(tok0 + row) * 1024 + h * 256 + ch * 8);
    }
    __syncthreads();
    f32x4 acc[16];
#pragma unroll
    for (int i = 0; i < 16; ++i) acc[i] = (f32x4){0.f, 0.f, 0.f, 0.f};
#pragma unroll
    for (int kk = 0; kk < 4; ++kk) {
        LAS unsigned char* px = Kp + ((kk * 32 + quad * 8 + (lq >> 2)) * KPST + 16 * wave + (lq & 3) * 4) * 2;
        const bf16x8 xf = mk8(lds_tr(px), lds_tr(px + 4 * KPST * 2));
#pragma unroll
        for (int vt = 0; vt < 16; ++vt) {
            LAS unsigned char* py = Vs + ((kk * 32 + quad * 8 + (lq >> 2)) * VST + vt * 16 + (lq & 3) * 4) * 2;
            acc[vt] = mfma16(xf, mk8(lds_tr(py), lds_tr(py + 4 * VST * 2)), acc[vt]);
        }
    }
    bf16_t* kl = (bf16_t*)(ws + OFF_KLOC) + (size_t)item * 256 * 128;
#pragma unroll
    for (int vt = 0; vt < 16; ++vt) { u32x2 w2; w2.x = pk2(acc[vt][0], acc[vt][1]); w2.y = pk2(acc[vt][2], acc[vt][3]); *(GAS u32x2*)(kl + (size_t)(vt * 16 + lq) * 128 + 16 * wave + quad * 4) = w2; }
    if (tid < 128) {
        float sum = 0.f;
#pragma unroll 8
        for (int s = 0; s < 128; ++s) sum += bf2f(*(const LAS unsigned short*)(Kp + (s * KPST + tid) * 2));
        ((GAS float*)(ws + OFF_NLOC))[(size_t)item * 128 + tid] = sum;
    }
}

__device__ __forceinline__ void mlstm_B(const Params& p, int li, LAS unsigned char* lds, int item) {
    int tid = threadIdx.x; asm volatile("" : "+v"(tid));
    const int wave = __builtin_amdgcn_readfirstlane(tid >> 6), lane = tid & 63, lq = lane & 15, quad = lane >> 4;
    const int half = item & 1, ci = item >> 1, bh = ci >> 4, c = ci & 15, b = bh >> 2, h = bh & 3;
    constexpr int QST = 136, VST = 144, CST = 136;
    LAS unsigned char* Qs = lds;
    LAS unsigned char* KWs = lds + 34816;
    LAS unsigned char* Vs = lds + 69632;
    LAS unsigned char* CTs = lds + 106496;
    LAS float* bcum = (LAS float*)(lds + 141312);
    LAS float* aval = bcum + 128; LAS float* Mt = aval + 128; LAS float* nvec = Mt + 128;
    unsigned char* ws = opaque_ws(p);
    const bf16_t* mv = (const bf16_t*)(ws + OFF_MV);
    const bf16_t* mo = (const bf16_t*)(ws + OFF_MO);
    const float* gates = (const float*)(ws + OFF_GATES);
    const bf16_t* mq = (const bf16_t*)(ws + OFF_MQ); const bf16_t* mk = (const bf16_t*)(ws + OFF_MK);
    bf16_t* mix = (bf16_t*)(ws + OFF_MIXE);
    const int tok0 = b * SEQ + c * 128;
    __syncthreads();
    float m_prev = 0.f;
    {
        f32x4 ca[8]; float na = 0.f;
#pragma unroll
        for (int i = 0; i < 8; ++i) ca[i] = (f32x4){0.f, 0.f, 0.f, 0.f};
        const GAS f32x2* msc = (const GAS f32x2*)(ws + OFF_MSC) + bh * 16;
        for (int c2 = 0; c2 < c; ++c2) {
            const f32x2 sc = msc[c2];
            const float Ml = fmaxf(m_prev, sc.x), dec = __expf(m_prev - Ml), wl = __expf(sc.x - Ml);
            const GAS u32x2* kl = (const GAS u32x2*)((const bf16_t*)(ws + OFF_KLOC) + (size_t)(bh * 16 + c2) * 256 * 128 + (size_t)half * 128 * 128) + tid;
#pragma unroll
            for (int i = 0; i < 8; ++i) { const u32x2 w2 = kl[512 * i]; ca[i] = ca[i] * dec + (f32x4){bflo(w2.x), bfhi(w2.x), bflo(w2.y), bfhi(w2.y)} * wl; }
            if (tid < 128) na = na * dec + wl * ((const GAS float*)(ws + OFF_NLOC))[(size_t)(bh * 16 + c2) * 128 + tid];
            m_prev = sc.y + Ml;
        }
#pragma unroll
        for (int i = 0; i < 8; ++i) {
            const int e4 = tid + 512 * i, v = e4 >> 5, d0 = (e4 & 31) * 4;
            u32x2 w2; w2.x = pk2(ca[i][0], ca[i][1]); w2.y = pk2(ca[i][2], ca[i][3]);
            *(LAS u32x2*)(CTs + (v * CST + d0) * 2) = w2;
        }
        if (tid < 128) nvec[tid] = na;
    }
    if (wave == 0) {
        const float bi = p.b_i[li * 4 + h], bfv = p.b_f[li * 4 + h];
        const int s0 = 2 * lane;
        const GAS float* g0 = (const GAS float*)(gates + (size_t)(tok0 + s0) * 8);
        const float i0 = g0[h] + bi, f0 = g0[4 + h] + bfv, i1 = g0[8 + h] + bi, f1 = g0[12 + h] + bfv;
        const float lf0 = logsigf_(f0), lf1 = logsigf_(f1);
        const float p1 = lf0 + lf1; float incl = p1;
#pragma unroll
        for (int o = 1; o < 64; o <<= 1) { const float t = __shfl_up(incl, o); if (lane >= o) incl += t; }
        const float excl = incl - p1, b0 = excl + lf0, b1 = excl + p1;
        const float a0 = i0 - b0, a1 = i1 - b1;
        float cm = fmaxf(a0, a1);
#pragma unroll
        for (int o = 1; o < 64; o <<= 1) { const float t = __shfl_up(cm, o); if (lane >= o) cm = fmaxf(cm, t); }
        float cmprev = __shfl_up(cm, 1); if (lane == 0) cmprev = -1e30f;
        const float M0 = fmaxf(m_prev, fmaxf(cmprev, a0)), M1 = fmaxf(m_prev, cm);
        bcum[s0] = b0; bcum[s0 + 1] = b1; aval[s0] = a0; aval[s0 + 1] = a1; Mt[s0] = M0; Mt[s0 + 1] = M1;
    }
#pragma unroll
    for (int i = 0; i < 4; ++i) {
        const int c2 = tid + 512 * i, row = c2 >> 4, ch = c2 & 15;
        *(LAS u32x4*)(Qs + (row * QST + ch * 8) * 2) = *(const GAS u32x4*)(mq + (size_t)(tok0 + row) * 512 + h * 128 + ch * 8);
        *(LAS u32x4*)(KWs + (row * QST + ch * 8) * 2) = *(const GAS u32x4*)(mk + (size_t)(tok0 + row) * 512 + h * 128 + ch * 8);
        *(LAS u32x4*)(Vs + (row * VST + ch * 8) * 2) = *(const GAS u32x4*)(mv + (size_t)(tok0 + row) * 1024 + h * 256 + half * 128 + ch * 8);
    }
    __syncthreads();
    const int trow = 16 * wave + lq;
    bf16x8 qf[4];
#pragma unroll
    for (int kk = 0; kk < 4; ++kk) qf[kk] = *(const LAS bf16x8*)(Qs + (trow * QST + kk * 32 + quad * 8) * 2);
    const float Mt_l = Mt[trow];
    unsigned wpk[8][2]; float dW = 0.f;
#pragma unroll
    for (int st = 0; st < 8; ++st) {
        if (st <= wave) {
            f32x4 s = (f32x4){0.f, 0.f, 0.f, 0.f};
#pragma unroll
            for (int kk = 0; kk < 4; ++kk) { const bf16x8 kf = *(const LAS bf16x8*)(KWs + ((16 * st + lq) * QST + kk * 32 + quad * 8) * 2); s = mfma16(kf, qf[kk], s); }
            const f32x4 av = *(const LAS f32x4*)(aval + 16 * st + quad * 4);
            float w[4];
#pragma unroll
            for (int jj = 0; jj < 4; ++jj) {
                const int sidx = 16 * st + quad * 4 + jj;
                const float e = (sidx <= trow) ? __expf(fminf(av[jj] - Mt_l, 0.f)) * s[jj] : 0.f;
                w[jj] = e; dW += e;
            }
            wpk[st][0] = pk2(w[0], w[1]); wpk[st][1] = pk2(w[2], w[3]);
        } else { wpk[st][0] = 0u; wpk[st][1] = 0u; }
    }
    dW += __shfl_xor(dW, 16); dW += __shfl_xor(dW, 32);
    __syncthreads();
#pragma unroll
    for (int st = 0; st < 8; ++st) { u32x2 w2; w2.x = wpk[st][0]; w2.y = wpk[st][1]; *(LAS u32x2*)(KWs + (trow * QST + 16 * st + quad * 4) * 2) = w2; }
    __syncthreads();
    f32x4 nW[8], nC[8];
#pragma unroll
    for (int i = 0; i < 8; ++i) { nW[i] = (f32x4){0.f, 0.f, 0.f, 0.f}; nC[i] = (f32x4){0.f, 0.f, 0.f, 0.f}; }
    const int kkmax = wave >> 1;
#pragma unroll
    for (int kk = 0; kk < 4; ++kk) {
        if (kk <= kkmax) {
            const bf16x8 wf = *(const LAS bf16x8*)(KWs + (trow * QST + kk * 32 + quad * 8) * 2);
#pragma unroll
            for (int vt = 0; vt < 8; ++vt) {
                LAS unsigned char* pa = Vs + ((kk * 32 + quad * 8 + (lq >> 2)) * VST + vt * 16 + (lq & 3) * 4) * 2;
                nW[vt] = mfma16(mk8(lds_tr(pa), lds_tr(pa + 4 * VST * 2)), wf, nW[vt]);
            }
        }
    }
#pragma unroll
    for (int kk = 0; kk < 4; ++kk)
#pragma unroll
        for (int vt = 0; vt < 8; ++vt) {
            const bf16x8 cf = *(const LAS bf16x8*)(CTs + ((vt * 16 + lq) * CST + kk * 32 + quad * 8) * 2);
            nC[vt] = mfma16(cf, qf[kk], nC[vt]);
        }
    float qn = 0.f;
#pragma unroll
    for (int e8 = 0; e8 < 4; ++e8) {
        const u32x4 qq = *(const LAS u32x4*)(Qs + (trow * QST + quad * 32 + e8 * 8) * 2);
        const f32x4 n0 = *(const LAS f32x4*)(nvec + quad * 32 + e8 * 8), n1 = *(const LAS f32x4*)(nvec + quad * 32 + e8 * 8 + 4);
        qn += bflo(qq.x) * n0[0] + bfhi(qq.x) * n0[1] + bflo(qq.y) * n0[2] + bfhi(qq.y) * n0[3] + bflo(qq.z) * n1[0] + bfhi(qq.z) * n1[1] + bflo(qq.w) * n1[2] + bfhi(qq.w) * n1[3];
    }
    qn += __shfl_xor(qn, 16); qn += __shfl_xor(qn, 32);
    {
        const float inter = __expf(m_prev - Mt_l);
        const float den = dW + inter * qn;
        const float mrow = bcum[trow] + Mt_l;
        const float inv = 1.0f / fmaxf(fabsf(den), __expf(-mrow));
        const size_t tok = (size_t)(tok0 + trow);
#pragma unroll
        for (int vt = 0; vt < 8; ++vt) {
            const int vcol = h * 256 + half * 128 + vt * 16 + quad * 4;
            const u32x2 og = *(const GAS u32x2*)(mo + tok * 1024 + vcol);
            const float h0 = (nW[vt][0] + inter * nC[vt][0]) * inv * bflo(og.x), h1 = (nW[vt][1] + inter * nC[vt][1]) * inv * bfhi(og.x);
            const float h2 = (nW[vt][2] + inter * nC[vt][2]) * inv * bflo(og.y), h3 = (nW[vt][3] + inter * nC[vt][3]) * inv * bfhi(og.y);
            u32x2 w2; w2.x = pk2(h0, h1); w2.y = pk2(h2, h3);
            *(GAS u32x2*)(mix + xb_off((int)tok, 1024 + vcol)) = w2;
        }
    }
}


#define XB_TMO      128
#define XB_XCNT(j)  (256  + 64 * (j))
#define XB_XSUB(j)  (1280 + 64 * (j))
#define XB_XGEN(j)  (2304 + 64 * (j))
#define XB_TOP      3328
#define XB_TOPGEN   3392
#define XB_SPIN_CAP (1u << 20)
__device__ __forceinline__ unsigned xb_ld(unsigned* p)              { return __hip_atomic_load((GAS unsigned*)p, __ATOMIC_RELAXED, __HIP_MEMORY_SCOPE_AGENT); }
__device__ __forceinline__ unsigned xb_add(unsigned* p, unsigned v) { return __hip_atomic_fetch_add((GAS unsigned*)p, v, __ATOMIC_RELAXED, __HIP_MEMORY_SCOPE_AGENT); }
__device__ __forceinline__ unsigned xb_xcc_id() { return (unsigned)__builtin_amdgcn_s_getreg((3 << 11) | 20) & 0xFu; }
#define XB_SPIN(cond, bar) do { unsigned _sp = 0; while (cond) { __builtin_amdgcn_s_sleep(1); \
    if ((++_sp & 255u) == 0u) { if (xb_ld(&(bar)[XB_TMO])) break; if (_sp > XB_SPIN_CAP) { atomicAdd(&(bar)[XB_TMO], 1u); break; } } } } while (0)
struct XcdBarrier { unsigned* bar; unsigned x; volatile LAS unsigned* st; };
__device__ __forceinline__ XcdBarrier xcd_barrier_post(unsigned* bar, volatile LAS unsigned* st) {
    XcdBarrier b; b.bar = bar; b.x = xb_xcc_id(); b.st = st;
    if (threadIdx.x == 0) (void)xb_add(&bar[XB_XCNT(b.x)], 1u);
    return b;
}
__device__ __forceinline__ void xcd_barrier_complete(unsigned* bar, unsigned x, unsigned& nloc, unsigned& nx) {
    const unsigned G = gridDim.x * gridDim.y * gridDim.z;
    unsigned sum, cnt, mine, sp = 0u;
    for (;;) {
        sum = 0u; cnt = 0u; mine = 0u;
#pragma unroll
        for (unsigned j = 0; j < 16; ++j) { const unsigned c = xb_ld(&bar[XB_XCNT(j)]); sum += c; cnt += (c > 0u) ? 1u : 0u; mine = (j == x) ? c : mine; }
        if (sum == G) break;
        __builtin_amdgcn_s_sleep(1);
        if ((++sp & 255u) == 0u) { if (xb_ld(&bar[XB_TMO])) break; if (sp > XB_SPIN_CAP) { atomicAdd(&bar[XB_TMO], 1u); break; } }
    }
    nloc = mine > 0u ? mine : 1u; nx = cnt > 0u ? cnt : 1u;
}
__device__ __forceinline__ void xcd_barrier(const XcdBarrier& b) {
    asm volatile("s_waitcnt vmcnt(0)" ::: "memory");
    __syncthreads();
    if (threadIdx.x == 0) {
        unsigned* bar = b.bar;
        __builtin_amdgcn_s_waitcnt(0);
        unsigned nloc = b.st[0], nx = b.st[1];
        if (nloc == 0u) { xcd_barrier_complete(bar, b.x, nloc, nx); b.st[0] = nloc; b.st[1] = nx; }
        const unsigned old = xb_add(&bar[XB_XSUB(b.x)], 1u);
        const unsigned gen = old / nloc;
        if (old + 1u == (gen + 1u) * nloc) {
            __builtin_amdgcn_fence(__ATOMIC_RELEASE, "agent");
            asm volatile("s_waitcnt vmcnt(0)" ::: "memory");
            const unsigned og = xb_add(&bar[XB_TOP], 1u);
            const unsigned tg = og / nx;
            if (og + 1u == (tg + 1u) * nx) xb_add(&bar[XB_TOPGEN], 1u);
            else XB_SPIN(xb_ld(&bar[XB_TOPGEN]) == tg, bar);
            __builtin_amdgcn_fence(__ATOMIC_ACQUIRE, "agent");
            xb_add(&bar[XB_XGEN(b.x)], 1u);
            asm volatile("s_waitcnt vmcnt(0)" ::: "memory");
        } else {
            XB_SPIN(xb_ld(&bar[XB_XGEN(b.x)]) == gen, bar);
            __builtin_amdgcn_fence(__ATOMIC_ACQUIRE, "agent");
            asm volatile("s_waitcnt vmcnt(0)" ::: "memory");
        }
    }
    __syncthreads();
}

__device__ __forceinline__ void phase_even_mix(const Params& p, int li, LAS unsigned char* lds, unsigned* ctr) {
    unsigned char* ws = opaque_ws(p);
    const bool x8 = (gridDim.x == 256);
    const int xcd = x8 ? (int)(blockIdx.x & 7) : 0, nq = x8 ? 96 : 768;
    unsigned* myctr = ctr + xcd * 32;
    for (;;) {
        __syncthreads();
        if (threadIdx.x == 0) *(LAS int*)(lds + QWORD_OFF) = (int)__hip_atomic_fetch_add((GAS unsigned*)myctr, 1u, __ATOMIC_RELAXED, __HIP_MEMORY_SCOPE_AGENT);
        __syncthreads();
        const int q = *(LAS int*)(lds + QWORD_OFF);
        if (q >= nq) break;
        int mla_it = -1, b_it = -1;
        if (x8) { if (q < 32) mla_it = q; else b_it = q - 32; } else { if (q < 256) mla_it = q; else b_it = 767 - q; }
        if (b_it >= 0) {
            const int item = x8 ? ((((2 * xcd + (b_it & 1)) * 16 + (15 - (b_it >> 2))) << 1) | ((b_it >> 1) & 1)) : b_it;
            mlstm_B(p, li, lds, item);
        } else {
            int qb, bh;
            if (x8) { qb = 7 - (mla_it >> 2); bh = xcd * 4 + (mla_it & 3); } else { qb = 7 - (mla_it >> 5); bh = mla_it & 31; }
            const int b = bh >> 3, h = bh & 7;
            AttnArgs a; a.q = (const bf16_t*)(ws + OFF_QB); a.k0 = (const bf16_t*)(ws + OFF_KNOPE); a.k1 = (const bf16_t*)(ws + OFF_KROPE); a.v = (const bf16_t*)(ws + OFF_VB);
            a.h = h; a.tokbase = b * SEQ; a.dil = 1; a.qb = qb; a.kt_begin = 0; a.kt_end = 4 * qb + 4;
            a.out = (bf16_t*)(ws + OFF_MIXE); a.ostride = 2048; a.ooff = h * 128; a.lse = nullptr; a.oblk = 1;
            attn_item<0>(a, lds);
        }
    }
}

__device__ __forceinline__ void phase_dilated(const Params& p, LAS unsigned char* lds) {
    unsigned char* ws = opaque_ws(p);
    const bool x8 = (gridDim.x == 256);
    const int nit = x8 ? 192 : 1536, step = x8 ? 32 : (int)gridDim.x, first = x8 ? (int)(blockIdx.x >> 3) : (int)blockIdx.x, base = x8 ? (int)(blockIdx.x & 7) * 192 : 0;
    for (int j = first; j < nit; j += step) {
        const int it = base + j;
        const int bh = it / 24, r = it % 24, g = r >> 3, rr = r & 7, b = bh >> 4, h = bh & 15;
        AttnArgs a; const bf16_t* qkv = (const bf16_t*)(ws + OFF_QKV);
        a.q = qkv; a.k0 = qkv + 2048; a.k1 = nullptr; a.v = qkv + 4096; a.h = h;
        a.out = (bf16_t*)(ws + OFF_OG) + (size_t)g * T * 2048; a.ostride = 2048; a.ooff = h * 128; a.lse = (float*)(ws + OFF_LSE) + (size_t)g * T * 16; a.oblk = 0;
        if (g == 2) {
            a.tokbase = b * SEQ + 2 * rr; a.dil = 16; a.qb = 0; a.kt_begin = 0; a.kt_end = 2;
            attn_item<2>(a, lds);
        } else {
            int n;
            if (g == 0) { a.dil = 1; a.tokbase = b * SEQ; n = rr; } else { a.dil = 4; a.tokbase = b * SEQ + (rr >> 1); n = rr & 1; }
            a.qb = n; a.kt_begin = (n > 0) ? 4 * n - 2 : 0; a.kt_end = 4 * n + 4;
            attn_item<1>(a, lds);
        }
    }
}

__device__ __forceinline__ void phase_merge(const Params& p) {
    unsigned char* ws = opaque_ws(p);
    const bf16_t* og = (const bf16_t*)(ws + OFF_OG); const GAS float* lse = (const GAS float*)(ws + OFF_LSE); bf16_t* mix = (bf16_t*)(ws + OFF_MIXO);
    int tid_ = threadIdx.x; asm volatile("" : "+v"(tid_));
    const size_t n = (size_t)T * 256, gt = (size_t)blockIdx.x * 512 + tid_, ngt = (size_t)gridDim.x * 512;
    for (size_t i = gt; i < n; i += ngt) {
        const size_t tok = i >> 8; const int c8 = (int)(i & 255), h = c8 >> 4;
        const float l0 = lse[tok * 16 + h], l1 = lse[(size_t)T * 16 + tok * 16 + h], l2 = lse[(size_t)2 * T * 16 + tok * 16 + h];
        const float mx = fmaxf(l0, fmaxf(l1, l2));
        float w0 = __builtin_amdgcn_exp2f(l0 - mx), w1 = __builtin_amdgcn_exp2f(l1 - mx), w2 = __builtin_amdgcn_exp2f(l2 - mx);
        const float inv = 1.0f / (w0 + w1 + w2); w0 *= inv; w1 *= inv; w2 *= inv;
        const u32x4 a = *(const GAS u32x4*)(og + tok * 2048 + c8 * 8), b = *(const GAS u32x4*)(og + (size_t)T * 2048 + tok * 2048 + c8 * 8), c = *(const GAS u32x4*)(og + (size_t)2 * T * 2048 + tok * 2048 + c8 * 8);
        u32x4 o;
        o.x = pk2(w0 * bflo(a.x) + w1 * bflo(b.x) + w2 * bflo(c.x), w0 * bfhi(a.x) + w1 * bfhi(b.x) + w2 * bfhi(c.x));
        o.y = pk2(w0 * bflo(a.y) + w1 * bflo(b.y) + w2 * bflo(c.y), w0 * bfhi(a.y) + w1 * bfhi(b.y) + w2 * bfhi(c.y));
        o.z = pk2(w0 * bflo(a.z) + w1 * bflo(b.z) + w2 * bflo(c.z), w0 * bfhi(a.z) + w1 * bfhi(b.z) + w2 * bfhi(c.z));
        o.w = pk2(w0 * bflo(a.w) + w1 * bflo(b.w) + w2 * bflo(c.w), w0 * bfhi(a.w) + w1 * bfhi(b.w) + w2 * bfhi(c.w));
        *(GAS u32x4*)(mix + xb_off((int)tok, c8 * 8)) = o;
    }
}

__device__ __forceinline__ void phase_final(const Params& p) {
    unsigned char* ws = opaque_ws(p);
    int tid_ = threadIdx.x; asm volatile("" : "+v"(tid_));
    const int wave = tid_ >> 6, lane = tid_ & 63, gw = blockIdx.x * 8 + wave, ngw = gridDim.x * 8;
    for (int row = gw; row < T; row += ngw) {
        const float rs = row_rstd((const float*)(ws + OFF_SSX) + (size_t)row * 32, 32, 1.0f / 2048.0f);
        const bf16_t* xbase = (const bf16_t*)(ws + OFF_XB);
        const GAS f32x4* gr = (const GAS f32x4*)p.norm_final + lane;
        GAS f32x4* orow = (GAS f32x4*)(p.out + (size_t)row * DM) + lane;
#pragma unroll
        for (int j = 0; j < 8; ++j) { const u32x2 w = *(const GAS u32x2*)(xbase + xb_off(row, 4 * (lane + 64 * j))); const f32x4 v = (f32x4){bflo(w.x), bfhi(w.x), bflo(w.y), bfhi(w.y)}; __builtin_nontemporal_store(v * rs * gr[64 * j], orow + 64 * j); }
    }
}

__device__ __forceinline__ void phase_mlp(const Params& p, int layer, LAS unsigned char* lds, const XcdBarrier& xb) {
    unsigned char* ws = opaque_ws(p);
    { EpiRelu2 E; E.ssx = (const float*)(ws + OFF_SSX); E.ub = (bf16_t*)(ws + OFF_U);
      run_gemm<32>(lds, (const bf16_t*)(ws + OFF_XB), (const bf16_t*)(ws + OFF_W1 + (size_t)layer * SZ_W1), FF, DM, E, E.ssx, true); }
    xcd_barrier(xb);
    asm volatile("" : "+s"(ws));
    { EpiRes E; E.xb = (bf16_t*)(ws + OFF_XB); E.ssx = (float*)(ws + OFF_SSX);
      run_gemm<0>(lds, (const bf16_t*)(ws + OFF_U), (const bf16_t*)(ws + OFF_W2 + (size_t)layer * SZ_W1), DM, FF, E, nullptr, true); }
    xcd_barrier(xb);
}

__global__ void __launch_bounds__(512, 2) trunk_fwd(Params p) {
    extern __shared__ __attribute__((aligned(16))) unsigned char shm[];
    LAS unsigned char* lds = (LAS unsigned char*)shm;
    cg::grid_group grid = cg::this_grid();
    unsigned char* ws = opaque_ws(p);
    if (threadIdx.x == 0) { *(LAS u32x4*)(lds + QWORD_OFF - 16) = (u32x4){0u, 0u, 0u, 0u}; }
    __syncthreads();
    const XcdBarrier xb = xcd_barrier_post((unsigned*)(ws + OFF_BAR), (volatile LAS unsigned*)(lds + QWORD_OFF - 16));
    phase_prep(p, lds);
    xcd_barrier(xb);
    if (p.out == nullptr) grid.sync();
#if defined(PROBE_PREP)
    phase_prep(p, lds);
    xcd_barrier(xb);
#endif
#pragma unroll 1
    for (int li = 0; li < 2; ++li) {
        asm volatile("" : "+s"(ws));
        asm volatile("" : "+s"(ws));
        { EpiIn E; E.ssx = (const float*)(ws + OFF_SSX); E.cq = (bf16_t*)(ws + OFF_CQ); E.ckv = (bf16_t*)(ws + OFF_CKV); E.mraw = (float*)(ws + OFF_MRAW); E.mv = (bf16_t*)(ws + OFF_MV);
          E.mo = (bf16_t*)(ws + OFF_MO); E.krope = (bf16_t*)(ws + OFF_KROPE); E.gates = (float*)(ws + OFF_GATES); E.sscq = (float*)(ws + OFF_SSCQ); E.ssckv = (float*)(ws + OFF_SSCKV);
          E.ropeA = (const f32x2*)(ws + OFF_ROPEA);
          run_gemm<32>(lds, (const bf16_t*)(ws + OFF_XB), (const bf16_t*)(ws + OFF_WIN + (size_t)li * SZ_WIN), 4096, DM, E, E.ssx, true, NIN); }
        { EpiPart E2; E2.part = (float*)(ws + OFF_PART);
          run_gemm_splitk(lds, (const bf16_t*)(ws + OFF_XB), (const bf16_t*)(ws + OFF_WIN + (size_t)li * SZ_WIN) + (size_t)4096 * 64, E2); }
        xcd_barrier(xb);
        for (int it = blockIdx.x; it < 256; it += gridDim.x) mlstm_A(p, li, lds, it);
        __syncthreads();
        asm volatile("" : "+s"(ws));
        { EpiUQ E; E.sscq = (const float*)(ws + OFF_SSCQ); E.qb = (bf16_t*)(ws + OFF_QB); E.ropeA = (const f32x2*)(ws + OFF_ROPEA);
          run_gemm<8>(lds, (const bf16_t*)(ws + OFF_CQ), (const bf16_t*)(ws + OFF_WUQ + (size_t)li * SZ_WUQ), 1536, 512, E, E.sscq, true); }
        asm volatile("" : "+s"(ws));
        { EpiUKV E; E.ssckv = (const float*)(ws + OFF_SSCKV); E.knope = (bf16_t*)(ws + OFF_KNOPE); E.vb = (bf16_t*)(ws + OFF_VB);
          run_gemm<8>(lds, (const bf16_t*)(ws + OFF_CKV), (const bf16_t*)(ws + OFF_WUKV + (size_t)li * SZ_WUKV), 2048, 512, E, E.ssckv, true); }
        xcd_barrier(xb);
        phase_even_mix(p, li, lds, (unsigned*)(ws + OFF_CTL) + 512 * li);
        xcd_barrier(xb);
#if defined(PROBE_MIX)
        phase_even_mix(p, li, lds, (unsigned*)(ws + OFF_CTL) + 64 * li + 32);
        xcd_barrier(xb);
#endif
        asm volatile("" : "+s"(ws));
        { EpiRes E; E.xb = (bf16_t*)(ws + OFF_XB); E.ssx = (float*)(ws + OFF_SSX);
          run_gemm<0>(lds, (const bf16_t*)(ws + OFF_MIXE), (const bf16_t*)(ws + OFF_WEVO + (size_t)li * SZ_WO), DM, DM, E, nullptr, true); }
        xcd_barrier(xb);
        phase_mlp(p, 2 * li, lds, xb);
        asm volatile("" : "+s"(ws));
        { EpiQKV E; E.ssx = (const float*)(ws + OFF_SSX); E.qkv = (bf16_t*)(ws + OFF_QKV); E.ropeB = (const f32x2*)(ws + OFF_ROPEB);
          run_gemm<32>(lds, (const bf16_t*)(ws + OFF_XB), (const bf16_t*)(ws + OFF_WQKV + (size_t)li * SZ_WQKV), 6144, DM, E, E.ssx, true); }
        xcd_barrier(xb);
        phase_dilated(p, lds);
        xcd_barrier(xb);
        phase_merge(p);
        xcd_barrier(xb);
#if defined(PROBE_DIL)
        phase_dilated(p, lds);
        xcd_barrier(xb);
        phase_merge(p);
        xcd_barrier(xb);
#endif
        asm volatile("" : "+s"(ws));
        { EpiRes E; E.xb = (bf16_t*)(ws + OFF_XB); E.ssx = (float*)(ws + OFF_SSX);
          run_gemm<0>(lds, (const bf16_t*)(ws + OFF_MIXO), (const bf16_t*)(ws + OFF_WODO + (size_t)li * SZ_WO), DM, DM, E, nullptr, true); }
        xcd_barrier(xb);
        phase_mlp(p, 2 * li + 1, lds, xb);
    }
    phase_final(p);
}

extern "C" void kernel_launch(void* const* d_in, const int* in_sizes, int n_in, void* d_out, int out_size, void* d_ws, size_t ws_size, hipStream_t stream) {
    static int grid = 0;
    if (grid == 0) {
        if (n_in != 18 || ws_size < WS_END) { fprintf(stderr, "kernel_launch: need 18 inputs and %zu bytes of workspace (got %d, %zu)\n", (size_t)WS_END, n_in, ws_size); grid = -1; return; }
        int dev = 0, cus = 0, per_cu = 0;
        hipGetDevice(&dev);
        hipDeviceGetAttribute(&cus, hipDeviceAttributeMultiprocessorCount, dev);
        if (hipFuncSetAttribute((const void*)trunk_fwd, hipFuncAttributeMaxDynamicSharedMemorySize, LDS_BYTES) != hipSuccess) { fprintf(stderr, "kernel_launch: hipFuncSetAttribute failed\n"); grid = -1; return; }
        if (hipOccupancyMaxActiveBlocksPerMultiprocessor(&per_cu, (const void*)trunk_fwd, 512, LDS_BYTES) != hipSuccess || per_cu < 1) { fprintf(stderr, "kernel_launch: occupancy query gave %d\n", per_cu); per_cu = 1; }
        (void)hipGetLastError();
        grid = cus * 1;
    }
    if (grid < 0) return;
    (void)hipMemsetAsync((char*)d_ws + OFF_CTL, 0, CTL_BYTES, stream);
    Params p{};
    p.x = (const float*)d_in[0]; p.norm_mix = (const float*)d_in[1]; p.norm_mlp = (const float*)d_in[2]; p.ev_w_in = (const float*)d_in[3];
    p.mla_q_norm = (const float*)d_in[4]; p.mla_w_uq = (const float*)d_in[5]; p.mla_kv_norm = (const float*)d_in[6]; p.mla_w_ukv = (const float*)d_in[7];
    p.conv_w = (const float*)d_in[8]; p.conv_b = (const float*)d_in[9]; p.b_i = (const float*)d_in[10]; p.b_f = (const float*)d_in[11];
    p.ev_w_out = (const float*)d_in[12]; p.od_w_qkv = (const float*)d_in[13]; p.od_w_out = (const float*)d_in[14]; p.mlp_w1 = (const float*)d_in[15];
    p.mlp_w2 = (const float*)d_in[16]; p.norm_final = (const float*)d_in[17];
    p.out = (float*)d_out; p.ws = (unsigned char*)d_ws;
    void* args[] = {&p};
    hipError_t e = hipLaunchCooperativeKernel((const void*)trunk_fwd, dim3(grid), dim3(512), args, LDS_BYTES, stream);
    if (e != hipSuccess) fprintf(stderr, "cooperative launch failed: %s (grid %d)\n", hipGetErrorString(e), grid);
}
```
